# Optimizing an MI355X kernel written in HIP

```python
import math
import jax, jax.numpy as jnp
from jax import lax
import numpy as np

D_MODEL = 2048
BATCH = 4
SEQ = 8192
DEPTH = 1

PLE_DIM = 256
HEAD_DIM = 128
N_FOX_HEADS = 8
N_DIFF_HEADS = 8
DIFF_QK_DIM = HEAD_DIM // 2
FOX_WIDTH = N_FOX_HEADS * HEAD_DIM
DIFF_WIDTH = N_DIFF_HEADS * HEAD_DIM
MIX_WIDTH = FOX_WIDTH + DIFF_WIDTH
IN_WIDTH = 4 * FOX_WIDTH + 4 * DIFF_WIDTH + N_FOX_HEADS
N_BUCKETS = 32
MAX_DISTANCE = 128
Q_BLOCK = 128
EPS = 1e-6

kernel_name = "hymba_fox_diffattn_ple_layer"


def rms_norm(x, gain, eps=EPS):
    xf = x.astype(jnp.float32)
    y = xf * lax.rsqrt(jnp.mean(xf * xf, axis=-1, keepdims=True) + eps)
    return (y * gain.astype(jnp.float32)).astype(x.dtype)


def t5_causal_bucket(n):
    max_exact = N_BUCKETS // 2
    is_small = n < max_exact
    nf = jnp.maximum(n, 1).astype(jnp.float32)
    large = max_exact + (jnp.log(nf / max_exact) / math.log(MAX_DISTANCE / max_exact)
                         * (N_BUCKETS - max_exact)).astype(jnp.int32)
    large = jnp.minimum(large, N_BUCKETS - 1)
    return jnp.where(is_small, n, large)


def to_heads(t, n_heads):
    b, s, _ = t.shape
    return t.reshape(b, s, n_heads, -1).transpose(0, 2, 1, 3)


def merge_heads(t):
    b, h, s, d = t.shape
    return t.transpose(0, 2, 1, 3).reshape(b, s, h * d)


def to_blocks(t):
    b, h, s = t.shape[:3]
    nb = s // Q_BLOCK
    t = t.reshape((b, h, nb, Q_BLOCK) + t.shape[3:])
    return jnp.moveaxis(t, 2, 0)


def from_blocks(t):
    nb, b, h, q, d = t.shape
    return jnp.moveaxis(t, 0, 2).reshape(b, h, nb * q, d)


def fox_attention(q, k, v, log_f):
    s_len, dh = q.shape[2], q.shape[3]
    scale = dh ** -0.5
    c = jnp.cumsum(log_f, axis=-1)
    kf = k.astype(jnp.float32)
    vf = v.astype(jnp.float32)
    k_pos = jnp.arange(s_len)
    nb = s_len // Q_BLOCK

    def block(args):
        qb, cb, i = args
        q_pos = i * Q_BLOCK + jnp.arange(Q_BLOCK)
        s = jnp.einsum('bhqd,bhkd->bhqk', qb.astype(jnp.float32), kf) * scale
        s = s + cb[..., :, None] - c[..., None, :]
        causal = k_pos[None, :] <= q_pos[:, None]
        s = jnp.where(causal, s, -jnp.inf)
        pr = jax.nn.softmax(s, axis=-1)
        return jnp.einsum('bhqk,bhkd->bhqd', pr, vf)

    out = lax.map(block, (to_blocks(q), to_blocks(c), jnp.arange(nb)))
    return from_blocks(out)


def diff_attention(q1, q2, k1, k2, v, bias_by_dist, lam):
    s_len, dq = q1.shape[2], q1.shape[3]
    scale = dq ** -0.5
    k1f = k1.astype(jnp.float32)
    k2f = k2.astype(jnp.float32)
    vf = v.astype(jnp.float32)
    k_pos = jnp.arange(s_len)
    nb = s_len // Q_BLOCK

    def block(args):
        q1b, q2b, i = args
        q_pos = i * Q_BLOCK + jnp.arange(Q_BLOCK)
        dist = q_pos[:, None] - k_pos[None, :]
        causal = dist >= 0
        bias = bias_by_dist[:, jnp.clip(dist, 0, s_len - 1)][None]

        def softmax_map(qb, kf):
            s = jnp.einsum('bhqd,bhkd->bhqk', qb.astype(jnp.float32), kf) * scale + bias
            return jax.nn.softmax(jnp.where(causal, s, -jnp.inf), axis=-1)

        a = softmax_map(q1b, k1f) - lam * softmax_map(q2b, k2f)
        return jnp.einsum('bhqk,bhkd->bhqd', a, vf)

    out = lax.map(block, (to_blocks(q1), to_blocks(q2), jnp.arange(nb)))
    return from_blocks(out)


def setup_inputs(seed: int = 0) -> dict:
    key = jax.random.key(seed)
    ks = jax.random.split(key, 20)
    f32 = jnp.float32
    nrm = lambda k, shape, s: (jax.random.normal(k, shape, f32) * s)
    return {
        "x": nrm(ks[0], (BATCH, SEQ, D_MODEL), 1.0),
        "p": nrm(ks[1], (DEPTH, BATCH, SEQ, PLE_DIM), 1.0),
        "attn_norm": 1.0 + nrm(ks[2], (DEPTH, D_MODEL), 0.02),
        "w_in": nrm(ks[3], (DEPTH, D_MODEL, IN_WIDTH), D_MODEL ** -0.5),
        "b_forget": 2.0 + nrm(ks[4], (DEPTH, N_FOX_HEADS), 0.5),
        "fox_q_norm": 1.0 + nrm(ks[5], (DEPTH, HEAD_DIM), 0.02),
        "fox_k_norm": 1.0 + nrm(ks[6], (DEPTH, HEAD_DIM), 0.02),
        "diff_q_norm": 1.0 + nrm(ks[7], (DEPTH, DIFF_QK_DIM), 0.02),
        "diff_k_norm": 1.0 + nrm(ks[8], (DEPTH, DIFF_QK_DIM), 0.02),
        "lambda_q1": nrm(ks[9], (DEPTH, DIFF_QK_DIM), 0.1),
        "lambda_k1": nrm(ks[10], (DEPTH, DIFF_QK_DIM), 0.1),
        "lambda_q2": nrm(ks[11], (DEPTH, DIFF_QK_DIM), 0.1),
        "lambda_k2": nrm(ks[12], (DEPTH, DIFF_QK_DIM), 0.1),
        "diff_out_norm": 1.0 + nrm(ks[13], (DEPTH, HEAD_DIM), 0.02),
        "w_out": nrm(ks[14], (DEPTH, MIX_WIDTH, D_MODEL), MIX_WIDTH ** -0.5),
        "rel_bias": nrm(ks[15], (N_BUCKETS, N_DIFF_HEADS), 0.5),
        "ple_proj": nrm(ks[16], (DEPTH, PLE_DIM, D_MODEL), 0.5 * PLE_DIM ** -0.5),
        "ple_gate_norm": 1.0 + nrm(ks[17], (DEPTH, D_MODEL), 0.02),
        "ple_gate": nrm(ks[18], (DEPTH, D_MODEL, D_MODEL), D_MODEL ** -0.5),
    }


def reference(x, p, attn_norm, w_in, b_forget, fox_q_norm, fox_k_norm, diff_q_norm,
              diff_k_norm, lambda_q1, lambda_k1, lambda_q2, lambda_k2, diff_out_norm,
              w_out, rel_bias, ple_proj, ple_gate_norm, ple_gate):
    b, s_len, _ = x.shape
    bias_by_dist = rel_bias.astype(jnp.float32)[t5_causal_bucket(jnp.arange(s_len))].T
    split_at = [FOX_WIDTH * j for j in range(1, 5)] + \
               [4 * FOX_WIDTH + DIFF_WIDTH * j for j in range(1, 5)]
    h = x
    for i in range(DEPTH):
        u = rms_norm(h, attn_norm[i])
        proj = jnp.einsum('bsd,de->bse', u, w_in[i])
        fq, fk, fv, fz, dq, dk, dv, dz, f_logit = jnp.split(proj, split_at, axis=-1)

        q_a = rms_norm(to_heads(fq, N_FOX_HEADS), fox_q_norm[i])
        k_a = rms_norm(to_heads(fk, N_FOX_HEADS), fox_k_norm[i])
        v_a = to_heads(fv, N_FOX_HEADS)
        log_f = jax.nn.log_sigmoid(
            (f_logit + b_forget[i]).astype(jnp.float32)).transpose(0, 2, 1)
        o_a = merge_heads(fox_attention(q_a, k_a, v_a, log_f))
        o_a = o_a * jax.nn.silu(fz.astype(jnp.float32))

        lambda_init = 0.8 - 0.6 * math.exp(-0.3 * i)
        lam = (jnp.exp(jnp.sum(lambda_q1[i].astype(jnp.float32) * lambda_k1[i].astype(jnp.float32)))
               - jnp.exp(jnp.sum(lambda_q2[i].astype(jnp.float32) * lambda_k2[i].astype(jnp.float32)))
               + lambda_init)
        q_b = rms_norm(dq.reshape(b, s_len, N_DIFF_HEADS, 2, DIFF_QK_DIM), diff_q_norm[i])
        k_b = rms_norm(dk.reshape(b, s_len, N_DIFF_HEADS, 2, DIFF_QK_DIM), diff_k_norm[i])
        q1 = q_b[:, :, :, 0].transpose(0, 2, 1, 3)
        q2 = q_b[:, :, :, 1].transpose(0, 2, 1, 3)
        k1 = k_b[:, :, :, 0].transpose(0, 2, 1, 3)
        k2 = k_b[:, :, :, 1].transpose(0, 2, 1, 3)
        v_b = to_heads(dv, N_DIFF_HEADS)
        o_b = diff_attention(q1, q2, k1, k2, v_b, bias_by_dist, lam)
        o_b = rms_norm(o_b, diff_out_norm[i]) * (1.0 - lambda_init)
        o_b = merge_heads(o_b) * jax.nn.silu(dz.astype(jnp.float32))

        mix = jnp.concatenate([o_a, o_b], axis=-1).astype(h.dtype)
        h = h + jnp.einsum('bse,ed->bsd', mix, w_out[i])

        e = jnp.einsum('bsk,kd->bsd', p[i], ple_proj[i])
        g = jax.nn.sigmoid(jnp.einsum('bsd,de->bse', rms_norm(h, ple_gate_norm[i]), ple_gate[i]))
        h = h + (g * e).astype(h.dtype)
    return h
```

```cpp
#include <hip/hip_runtime.h>
#include <hip/hip_cooperative_groups.h>
#include <cstdio>
#include <cstdint>
namespace cg = cooperative_groups;

constexpr float LOG2E = 1.4426950408889634f;
namespace pg8 {
#define PG8_LAS __attribute__((address_space(3)))
typedef unsigned short bf16_t;
typedef short bf16x8 __attribute__((ext_vector_type(8)));
typedef float f32x4 __attribute__((ext_vector_type(4)));
typedef unsigned u32x4 __attribute__((ext_vector_type(4)));
constexpr int BM = 256, BK = 64, HALF = 128, HTB = HALF * BK * 2  , STAGE_BYTES = 8 * HTB, NXCD = 8, WGM = 2;

__host__ __device__ __forceinline__ int lds_byte(int r, int c) { const int st = (r >> 4) * 2 + (c >> 5), rr = r & 15, cc = c & 31, ob = rr * 64 + cc * 2; return st * 1024 + (ob ^ (((ob >> 9) & 1) << 5)); }
__host__ __device__ __forceinline__ void stage_rc(int b, int& R, int& C) { const int st = b / 1024, sb = b % 1024, swz = sb ^ (((sb >> 9) & 1) << 5); R = (st >> 1) * 16 + swz / 64; C = (st & 1) * 32 + (swz % 64) / 2; }
__host__ __device__ __forceinline__ int perm32(int rho) { const int n = rho >> 4, i = rho & 15; return 8 * (i >> 2) + 4 * n + (i & 3); }

struct Unit { int pm, pn; };
struct Gemm { const bf16_t* A; const bf16_t* Bt; int M, N, K; };

struct StaticOrder {
    int nM, nN, nwg, G, c;
    __host__ __device__ void init(int M, int N, int G_, int c_) { nM = M / BM; nN = N / BM; nwg = nM * nN; G = G_; c = c_; }
    __host__ __device__ bool next(int i, Unit& u) const {
        const long L = (long)i * G + c; if (L >= nwg) return false;
        int wgid = (int)L; { const int q = nwg / NXCD, r = nwg % NXCD, xcd = wgid % NXCD, off = wgid / NXCD; wgid = (xcd < r ? xcd * (q + 1) : r * (q + 1) + (xcd - r) * q) + off; }
        const int nig = WGM * nN, gid = wgid / nig, fm = gid * WGM, gsz = (nM - fm) < WGM ? (nM - fm) : WGM;
        u.pm = fm + ((wgid % nig) % gsz); u.pn = (wgid % nig) / gsz; return true;
    }
    __device__ __forceinline__ void a_ready(const Unit&) const {}
    __device__ __forceinline__ void done(const Unit&) const {}
};

__device__ __forceinline__ unsigned cvt_pk_bf16(float lo, float hi) {
    typedef __bf16 bf2_t __attribute__((ext_vector_type(2))); typedef float f2_t __attribute__((ext_vector_type(2)));
    f2_t v = {lo, hi}; return __builtin_bit_cast(unsigned, __builtin_convertvector(v, bf2_t));
}
__device__ __forceinline__ u32x4 pack8(const f32x4 a, const f32x4 b) { u32x4 w; w.x = cvt_pk_bf16(a[0], a[1]); w.y = cvt_pk_bf16(a[2], a[3]); w.z = cvt_pk_bf16(b[0], b[1]); w.w = cvt_pk_bf16(b[2], b[3]); return w; }
__device__ __forceinline__ float dot4(const f32x4 a) { return (a[0] * a[0] + a[1] * a[1]) + (a[2] * a[2] + a[3] * a[3]); }

struct EpiPlain {
    static constexpr bool PERM = true, AFTER_DRAIN = false;
    bf16_t* O; int ldc;
    __device__ __forceinline__ void operator()(const f32x4 (&acc)[2][2][4][2], const Unit& u, int wr, int wc, int fr, int fq) const {
        const int row0 = u.pm * BM + wr * 64 + fr, col0 = u.pn * BM + wc * 32 + 8 * fq;
#pragma unroll
        for (int ai = 0; ai < 2; ++ai)
#pragma unroll
            for (int m = 0; m < 4; ++m) { bf16_t* rowp = O + (size_t)(row0 + ai * HALF + m * 16) * ldc + col0;
#pragma unroll
                for (int bj = 0; bj < 2; ++bj) *(u32x4*)(rowp + bj * HALF) = pack8(acc[ai][bj][m][0], acc[ai][bj][m][1]); }
    }
};

struct EpiProj {
    static constexpr bool PERM = true, AFTER_DRAIN = false;
    bf16_t* O; const float* gtab; PG8_LAS float* red;
    __device__ __forceinline__ void operator()(const f32x4 (&acc)[2][2][4][2], const Unit& u, int wr, int wc, int fr, int fq) const {
        const int type = u.pn >> 2;
        const int row0 = u.pm * BM + wr * 64 + fr;
        bf16_t* const Ot = O + (((size_t)type * 4 + (size_t)(u.pm >> 5)) * 8 + (size_t)((u.pn & 3) * 2)) * 8192 * 128 + (size_t)(u.pm & 31) * 256 * 128;
        unsigned char* const Ot1 = (unsigned char*)(Ot + (size_t)8192 * 128);
        const unsigned voff = (unsigned)(((wr * 64 + fr) * 128 + wc * 32 + 8 * fq) * 2);
        const bool isnorm = (type == 0) || (type == 1) || (type == 4) || (type == 5);
        if (!isnorm) {
#pragma unroll
            for (int ai = 0; ai < 2; ++ai)
#pragma unroll
                for (int m = 0; m < 4; ++m) { const unsigned vo = voff + (unsigned)((ai * HALF + m * 16) * 256);
                    *(u32x4*)((unsigned char*)Ot + vo) = pack8(acc[ai][0][m][0], acc[ai][0][m][1]); *(u32x4*)(Ot1 + vo) = pack8(acc[ai][1][m][0], acc[ai][1][m][1]); }
        } else {
            const bool isdiff = type >= 4;
#pragma unroll
            for (int ai = 0; ai < 2; ++ai)
#pragma unroll
                for (int m = 0; m < 4; ++m)
#pragma unroll
                    for (int bj = 0; bj < 2; ++bj) {
                        float s = dot4(acc[ai][bj][m][0]) + dot4(acc[ai][bj][m][1]);
                        s += __shfl_xor(s, 16); s += __shfl_xor(s, 32);
                        if (fq == 0) red[(ai * HALF + wr * 64 + m * 16 + fr) * 8 + bj * 4 + wc] = s;
                    }
            asm volatile("s_waitcnt lgkmcnt(0)" ::: "memory"); __builtin_amdgcn_s_barrier(); asm volatile("" ::: "memory");
            const float* gp = gtab + ((type & 1) + ((type >> 2) << 1)) * 128 + wc * 32 + 8 * fq;
            const f32x4 g0 = *(const f32x4*)(gp), g1 = *(const f32x4*)(gp + 4);
            const float invn = isdiff ? (1.0f / 64.0f) : (1.0f / 128.0f);
#pragma unroll
            for (int ai = 0; ai < 2; ++ai)
#pragma unroll
                for (int m = 0; m < 4; ++m) { const int rl = ai * HALF + wr * 64 + m * 16 + fr; const unsigned vo = voff + (unsigned)((ai * HALF + m * 16) * 256);
#pragma unroll
                    for (int bj = 0; bj < 2; ++bj) {
                        const f32x4 pr = *(const PG8_LAS f32x4*)(red + rl * 8 + bj * 4);
                        const float ss = isdiff ? ((wc < 2) ? (pr[0] + pr[1]) : (pr[2] + pr[3])) : ((pr[0] + pr[1]) + (pr[2] + pr[3]));
                        const float rstd = __builtin_amdgcn_rsqf(ss * invn + 1e-6f);
                        *(u32x4*)((bj ? Ot1 : (unsigned char*)Ot) + vo) = pack8(acc[ai][bj][m][0] * g0 * rstd, acc[ai][bj][m][1] * g1 * rstd);
                    } }
        }
    }
};

struct EpiOut {
    static constexpr bool PERM = true, AFTER_DRAIN = false;
    const float* x; bf16_t* a2; float* sumsq;
    __device__ __forceinline__ void operator()(const f32x4 (&acc)[2][2][4][2], const Unit& u, int wr, int wc, int fr, int fq) const {
        const int row0 = u.pm * BM + wr * 64 + fr, col0 = u.pn * BM + wc * 32 + 8 * fq;
#pragma unroll
        for (int ai = 0; ai < 2; ++ai) {
            f32x4 xr[4][2][2];
#pragma unroll
            for (int m = 0; m < 4; ++m)
#pragma unroll
                for (int bj = 0; bj < 2; ++bj) { const size_t off = (size_t)(row0 + ai * HALF + m * 16) * 2048 + col0 + bj * HALF;
                    xr[m][bj][0] = *(const f32x4*)(x + off); xr[m][bj][1] = *(const f32x4*)(x + off + 4); }
            asm volatile("" ::: "memory");
#pragma unroll
            for (int m = 0; m < 4; ++m) { const int row = row0 + ai * HALF + m * 16; float ss = 0.f;
#pragma unroll
                for (int bj = 0; bj < 2; ++bj) { const size_t off = (size_t)row * 2048 + col0 + bj * HALF;
                    const f32x4 h0 = xr[m][bj][0] + acc[ai][bj][m][0], h1 = xr[m][bj][1] + acc[ai][bj][m][1];
                    ss += dot4(h0) + dot4(h1);
                    *(u32x4*)(a2 + off) = pack8(h0, h1); }
                ss += __shfl_xor(ss, 16); ss += __shfl_xor(ss, 32);
                if (fq == 0) atomicAdd(sumsq + row, ss); }
        }
    }
};

struct EpiGate {
    static constexpr bool PERM = true, AFTER_DRAIN = false;
    float* out; const bf16_t* h; const bf16_t* e; const float* sumsq;
    __device__ __forceinline__ void operator()(const f32x4 (&acc)[2][2][4][2], const Unit& u, int wr, int wc, int fr, int fq) const {
        const int row0 = u.pm * BM + wr * 64 + fr, col0 = u.pn * BM + wc * 32 + 8 * fq;
#pragma unroll
        for (int ai = 0; ai < 2; ++ai) {
            u32x4 hv[4][2], ev[4][2]; float sq[4];
#pragma unroll
            for (int m = 0; m < 4; ++m) { const int row = row0 + ai * HALF + m * 16; sq[m] = sumsq[row];
#pragma unroll
                for (int bj = 0; bj < 2; ++bj) { const size_t off = (size_t)row * 2048 + col0 + bj * HALF; hv[m][bj] = *(const u32x4*)(h + off); ev[m][bj] = *(const u32x4*)(e + off); } }
            asm volatile("" ::: "memory");
#pragma unroll
            for (int m = 0; m < 4; ++m) { const int row = row0 + ai * HALF + m * 16;
                const float nr = -LOG2E * __builtin_amdgcn_rsqf(sq[m] * (1.0f / 2048.0f) + 1e-6f);
#pragma unroll
                for (int bj = 0; bj < 2; ++bj) { const size_t off = (size_t)row * 2048 + col0 + bj * HALF;
                    f32x4 h0, h1;
#pragma unroll
                    for (int k = 0; k < 2; ++k) { h0[2 * k] = __uint_as_float(hv[m][bj][k] << 16); h0[2 * k + 1] = __uint_as_float(hv[m][bj][k] & 0xffff0000u);
                        h1[2 * k] = __uint_as_float(hv[m][bj][2 + k] << 16); h1[2 * k + 1] = __uint_as_float(hv[m][bj][2 + k] & 0xffff0000u); }
                    float ef[8];
#pragma unroll
                    for (int k = 0; k < 4; ++k) { ef[2 * k] = __uint_as_float(ev[m][bj][k] << 16); ef[2 * k + 1] = __uint_as_float(ev[m][bj][k] & 0xffff0000u); }
#pragma unroll
                    for (int k = 0; k < 4; ++k) {
                        h0[k] += ef[k] * __builtin_amdgcn_rcpf(1.0f + __builtin_amdgcn_exp2f(acc[ai][bj][m][0][k] * nr));
                        h1[k] += ef[4 + k] * __builtin_amdgcn_rcpf(1.0f + __builtin_amdgcn_exp2f(acc[ai][bj][m][1][k] * nr)); }
                    *(f32x4*)(out + off) = h0; *(f32x4*)(out + off + 4) = h1; } }
        }
    }
};

template <class Epi, class Sched, bool ALIGN_EPI = false, bool SP2 = false>
__device__ __forceinline__ void gemm_phase(PG8_LAS unsigned char* lds, const Gemm g, const Sched& S, const Epi& E) {
    int tid_ = threadIdx.x; asm volatile("" : "+v"(tid_));
    const int tid = tid_, wid = __builtin_amdgcn_readfirstlane(tid >> 6), lane = tid & 63, wr = wid >> 2, wc = wid & 3, fr = lane & 15, fq = lane >> 4;
    int K_ = g.K; asm volatile("" : "+s"(K_)); const int K = K_, nt = K / BK;
    unsigned voffA[2], voffB[2];
#pragma unroll
    for (int i = 0; i < 2; ++i) { int R, C; stage_rc(tid * 16 + i * 8192, R, C); const int Rb = Epi::PERM ? ((R & ~31) + perm32(R & 31)) : R;
        voffA[i] = (unsigned)(R * K + C) * 2u; voffB[i] = (unsigned)(Rb * K + C) * 2u; }
    const size_t kstep = (size_t)(BK * 2);
    const size_t hstep = (size_t)HALF * K * 2;
    const size_t tstep = 2 * hstep;
    const unsigned ldsw = (unsigned)wid * 1024u;
    const int aoff = lds_byte(wr * 64 + fr, fq * 8), boff = lds_byte(wc * 32 + fr, fq * 8);
#define PG8_SA(b, h) (((b) * 2 + (h)) * HTB)
#define PG8_SB(b, h) ((4 + (b) * 2 + (h)) * HTB)
#define PG8_STAGE(bufoff, gbase, voff) do { _Pragma("unroll") for (int _i = 0; _i < 2; ++_i) \
        __builtin_amdgcn_global_load_lds((const unsigned*)((const char*)(gbase) + (voff)[_i]), (PG8_LAS unsigned*)(lds + (bufoff) + ldsw + _i * 8192), 16, 0, 0); } while (0)
#define PG8_LDA(dst, b, h) do { _Pragma("unroll") for (int m = 0; m < 4; ++m) _Pragma("unroll") for (int k = 0; k < 2; ++k) dst[m][k] = *(const PG8_LAS bf16x8*)(lds + PG8_SA(b, h) + aoff + m * 2048 + k * 1024); } while (0)
#define PG8_LDB(dst, b, h) do { _Pragma("unroll") for (int n = 0; n < 2; ++n) _Pragma("unroll") for (int k = 0; k < 2; ++k) dst[n][k] = *(const PG8_LAS bf16x8*)(lds + PG8_SB(b, h) + boff + n * 2048 + k * 1024); } while (0)
#define PG8_MMA(ai, bj, At, Bt) do { __builtin_amdgcn_s_setprio(1); _Pragma("unroll") for (int m = 0; m < 4; ++m) _Pragma("unroll") for (int n = 0; n < 2; ++n) _Pragma("unroll") for (int k = 0; k < 2; ++k) \
        acc[ai][bj][m][n] = __builtin_amdgcn_mfma_f32_16x16x32_bf16(Bt[n][k], At[m][k], acc[ai][bj][m][n], 0, 0, 0); __builtin_amdgcn_s_setprio(0); } while (0)
#define PG8_WAIT_V(n) asm volatile("s_waitcnt vmcnt(" #n ")" ::: "memory")
#define PG8_WAIT_L(n) asm volatile("s_waitcnt lgkmcnt(" #n ")" ::: "memory")
#define PG8_BAR __builtin_amdgcn_s_barrier()
#define PG8_SCHED __builtin_amdgcn_sched_barrier(0)
    Unit cur, nxt; int ui = 0;
    if (!S.next(0, cur)) return;
    f32x4 acc[2][2][4][2];
#pragma unroll
    for (int a = 0; a < 2; ++a)
#pragma unroll
        for (int b = 0; b < 2; ++b)
#pragma unroll
            for (int m = 0; m < 4; ++m)
#pragma unroll
                for (int n = 0; n < 2; ++n) acc[a][b][m][n] = (f32x4){0.f, 0.f, 0.f, 0.f};
    bf16x8 At[4][2], B0[2][2], B1[2][2];
    const char* cA = (const char*)g.A + (size_t)cur.pm * tstep; const char* cB = (const char*)g.Bt + (size_t)cur.pn * tstep;
    S.a_ready(cur);
    if constexpr (SP2) {
        PG8_STAGE(PG8_SB(0, 0), cB, voffB); PG8_STAGE(PG8_SB(0, 1), cB + hstep, voffB); PG8_STAGE(PG8_SA(0, 0), cA, voffA); PG8_STAGE(PG8_SA(0, 1), cA + hstep, voffA);
        if (wr == 1) PG8_BAR;
        PG8_WAIT_V(2); PG8_BAR;
        PG8_STAGE(PG8_SB(1, 0), cB + kstep, voffB); PG8_STAGE(PG8_SA(1, 0), cA + kstep, voffA); PG8_STAGE(PG8_SB(1, 1), cB + hstep + kstep, voffB);
        PG8_WAIT_V(6); PG8_BAR;
    } else {
        PG8_STAGE(PG8_SB(0, 0), cB, voffB); PG8_STAGE(PG8_SA(0, 0), cA, voffA); PG8_STAGE(PG8_SB(0, 1), cB + hstep, voffB); PG8_STAGE(PG8_SA(0, 1), cA + hstep, voffA);
        if (wr == 1) PG8_BAR;
        PG8_WAIT_V(4); PG8_BAR;
        PG8_STAGE(PG8_SB(1, 0), cB + kstep, voffB); PG8_STAGE(PG8_SA(1, 0), cA + kstep, voffA); PG8_STAGE(PG8_SB(1, 1), cB + hstep + kstep, voffB);
        PG8_WAIT_V(6); PG8_BAR;
    }
    for (;;) {
        const bool has_next = S.next(ui + 1, nxt);
        const char* nA = has_next ? (const char*)g.A + (size_t)nxt.pm * tstep : cA; const char* nB = has_next ? (const char*)g.Bt + (size_t)nxt.pn * tstep : cB;
        for (int t = 0; t < nt; t += 2) {
            const bool last = (t == nt - 2);
            const char* a1 = cA + (size_t)(t + 1) * kstep;
            const char* a2 = last ? nA : cA + (size_t)(t + 2) * kstep; const char* b2 = last ? nB : cB + (size_t)(t + 2) * kstep;
            const char* a3 = a2 + kstep; const char* b3 = b2 + kstep;
            if (last && has_next) S.a_ready(nxt);
            if constexpr (SP2) {
            PG8_LDB(B0, 0, 0); PG8_LDB(B1, 0, 1); PG8_SCHED; PG8_LDA(At, 0, 0); PG8_STAGE(PG8_SA(1, 1), a1 + hstep, voffA);
            PG8_WAIT_V(8); PG8_WAIT_L(0); PG8_BAR; PG8_MMA(0, 0, At, B0); PG8_MMA(0, 1, At, B1); PG8_BAR; PG8_SCHED;
            PG8_LDA(At, 0, 1); PG8_STAGE(PG8_SB(0, 0), b2, voffB); PG8_STAGE(PG8_SB(0, 1), b2 + hstep, voffB); PG8_STAGE(PG8_SA(0, 0), a2, voffA);
            PG8_WAIT_V(8); PG8_WAIT_L(0); PG8_BAR; PG8_MMA(1, 0, At, B0); PG8_MMA(1, 1, At, B1); PG8_BAR; PG8_SCHED;
            PG8_LDB(B0, 1, 0); PG8_LDB(B1, 1, 1); PG8_SCHED; PG8_LDA(At, 1, 0); PG8_STAGE(PG8_SA(0, 1), a2 + hstep, voffA);
            PG8_WAIT_V(8); PG8_WAIT_L(0); PG8_BAR; PG8_MMA(0, 0, At, B0); PG8_MMA(0, 1, At, B1); PG8_BAR; PG8_SCHED;
            PG8_LDA(At, 1, 1); PG8_STAGE(PG8_SB(1, 0), b3, voffB); PG8_STAGE(PG8_SB(1, 1), b3 + hstep, voffB); PG8_STAGE(PG8_SA(1, 0), a3, voffA);
            PG8_WAIT_V(8); PG8_WAIT_L(0); PG8_BAR; PG8_MMA(1, 0, At, B0); PG8_MMA(1, 1, At, B1); PG8_BAR; PG8_SCHED;
            } else {
            PG8_LDB(B0, 0, 0); PG8_SCHED; PG8_LDA(At, 0, 0); PG8_STAGE(PG8_SA(1, 1), a1 + hstep, voffA);
            PG8_WAIT_L(8); PG8_BAR; PG8_WAIT_L(0); PG8_MMA(0, 0, At, B0); PG8_BAR; PG8_SCHED;
            PG8_LDB(B1, 0, 1); PG8_STAGE(PG8_SB(0, 0), b2, voffB);
            PG8_BAR; PG8_WAIT_L(0); PG8_MMA(0, 1, At, B1); PG8_BAR;
            PG8_LDA(At, 0, 1); PG8_STAGE(PG8_SA(0, 0), a2, voffA);
            PG8_BAR; PG8_WAIT_L(0); PG8_MMA(1, 0, At, B0); PG8_BAR; PG8_SCHED;
            PG8_STAGE(PG8_SB(0, 1), b2 + hstep, voffB);
            PG8_WAIT_V(6); PG8_BAR; PG8_MMA(1, 1, At, B1); PG8_BAR;
            PG8_LDB(B0, 1, 0); PG8_SCHED; PG8_LDA(At, 1, 0); PG8_STAGE(PG8_SA(0, 1), a2 + hstep, voffA);
            PG8_WAIT_L(8); PG8_BAR; PG8_WAIT_L(0); PG8_MMA(0, 0, At, B0); PG8_BAR; PG8_SCHED;
            PG8_LDB(B1, 1, 1); PG8_STAGE(PG8_SB(1, 0), b3, voffB);
            PG8_BAR; PG8_WAIT_L(0); PG8_MMA(0, 1, At, B1); PG8_BAR;
            PG8_LDA(At, 1, 1); PG8_STAGE(PG8_SA(1, 0), a3, voffA);
            PG8_BAR; PG8_WAIT_L(0); PG8_MMA(1, 0, At, B0); PG8_BAR; PG8_SCHED;
            PG8_STAGE(PG8_SB(1, 1), b3 + hstep, voffB);
            PG8_WAIT_V(6); PG8_BAR; PG8_MMA(1, 1, At, B1); PG8_BAR;
            }
        }
        if constexpr (ALIGN_EPI) { if (wr == 0) PG8_BAR; }
        if constexpr (!Epi::AFTER_DRAIN) { E(acc, cur, wr, wc, fr, fq); S.done(cur); }
        if (!has_next) break;
#pragma unroll
        for (int a = 0; a < 2; ++a)
#pragma unroll
            for (int b = 0; b < 2; ++b)
#pragma unroll
                for (int m = 0; m < 4; ++m)
#pragma unroll
                    for (int n = 0; n < 2; ++n) acc[a][b][m][n] = (f32x4){0.f, 0.f, 0.f, 0.f};
        cur = nxt; cA = nA; cB = nB; ++ui;
        if constexpr (ALIGN_EPI) { if (wr == 1) PG8_BAR; }
    }
    PG8_WAIT_V(0);
    if constexpr (!ALIGN_EPI) { if (wr == 0) PG8_BAR; }
    PG8_BAR;
    if constexpr (Epi::AFTER_DRAIN) { E.fused(acc, cur, wr, wc, fr, fq, lds, wid, lane); S.done(cur); }
#undef PG8_SA
#undef PG8_SB
#undef PG8_STAGE
#undef PG8_LDA
#undef PG8_LDB
#undef PG8_MMA
#undef PG8_WAIT_V
#undef PG8_WAIT_L
#undef PG8_BAR
#undef PG8_SCHED
}
}
#define LAS __attribute__((address_space(3)))
typedef unsigned short bf16_t;
typedef short bf16x8 __attribute__((ext_vector_type(8)));
typedef short s16x4 __attribute__((ext_vector_type(4)));
typedef float f32x4 __attribute__((ext_vector_type(4)));
typedef float f32x16 __attribute__((ext_vector_type(16)));
typedef unsigned u32x4 __attribute__((ext_vector_type(4)));
typedef unsigned u32x2 __attribute__((ext_vector_type(2)));
using pg8::cvt_pk_bf16;

constexpr int B_ = 4, S_ = 8192, DM = 2048, M_ = B_ * S_, NP = 8192, INW = 8200, PLE = 256, NT = 512;
constexpr int LDS_BYTES = 144 * 1024;
constexpr size_t WS_CTL = 0, WS_TAB = 4096, WS_SUMSQ = 16384, WS_LOGF = WS_SUMSQ + 131072, WS_C = WS_LOGF + (1u << 20), WS_WIN = WS_C + (1u << 20);
constexpr size_t WS_WOUT = WS_WIN + (size_t)NP * DM * 2, WS_WG = WS_WOUT + (size_t)DM * DM * 2, WS_WP = WS_WG + (size_t)DM * DM * 2, WS_PB = WS_WP + (size_t)DM * PLE * 2;
constexpr size_t WS_U = WS_PB + (size_t)M_ * PLE * 2, WS_E = WS_U + (size_t)M_ * DM * 2, WS_QKVZ = WS_E + (size_t)M_ * DM * 2, WS_END = WS_QKVZ + (size_t)M_ * NP * 2;
constexpr size_t WS_BAR = WS_END, WS_TOTAL = WS_END + 16384;
constexpr size_t WS_MIX = WS_U;
constexpr size_t WS_A2 = WS_QKVZ;
constexpr int TAB_LAM = 1056, TAB_AQ2 = 1057, TAB_DBOUND = 1058, TAB_GAIN = 1088;
constexpr int QN = 384;

struct Params { const float* in[19]; float* out; unsigned char* ws; };
enum { I_X = 0, I_P, I_ATTN_NORM, I_W_IN, I_B_FORGET, I_FQN, I_FKN, I_DQN, I_DKN, I_LQ1, I_LK1, I_LQ2, I_LK2, I_DON, I_W_OUT, I_REL_BIAS, I_PLE_PROJ, I_PGN, I_PLE_GATE };

__device__ __forceinline__ float wave_sum(float v) {
#pragma unroll
    for (int o = 32; o >= 1; o >>= 1) v += __shfl_xor(v, o);
    return v;
}
__device__ __forceinline__ float wave_max(float v) {
#pragma unroll
    for (int o = 32; o >= 1; o >>= 1) v = fmaxf(v, __shfl_xor(v, o));
    return v;
}
__device__ __forceinline__ float silu_f(float z) { return z * __builtin_amdgcn_rcpf(1.0f + __builtin_amdgcn_exp2f(-LOG2E * z)); }
__device__ __forceinline__ float bf_lo(unsigned v) { return __uint_as_float(v << 16); }
__device__ __forceinline__ float bf_hi(unsigned v) { return __uint_as_float(v & 0xffff0000u); }

__device__ __forceinline__ void transpose_tile_wave(const float* W, int ldw, int K, bf16_t* Wt, int kt, int ntile, LAS float* tile, int lane, const float* kscale = nullptr) {
    const int k0 = kt * 64, n0 = ntile * 64, kr = lane >> 4, n4 = (lane & 15) * 4;
#pragma unroll
    for (int h = 0; h < 2; ++h) { f32x4 v[8];
#pragma unroll
        for (int i = 0; i < 8; ++i) v[i] = *(const f32x4*)(W + (size_t)(k0 + (h * 8 + i) * 4 + kr) * ldw + n0 + n4);
#pragma unroll
        for (int i = 0; i < 8; ++i) *(LAS f32x4*)(tile + ((h * 8 + i) * 4 + kr) * 68 + n4) = v[i]; }
    asm volatile("s_waitcnt lgkmcnt(0)" ::: "memory");
#pragma unroll
    for (int kc = 0; kc < 8; ++kc) { float v[8];
#pragma unroll
        for (int j = 0; j < 8; ++j) v[j] = tile[(kc * 8 + j) * 68 + lane];
        if (kscale) {
#pragma unroll
            for (int j = 0; j < 8; ++j) v[j] *= kscale[k0 + kc * 8 + j]; }
        u32x4 w; w.x = cvt_pk_bf16(v[0], v[1]); w.y = cvt_pk_bf16(v[2], v[3]); w.z = cvt_pk_bf16(v[4], v[5]); w.w = cvt_pk_bf16(v[6], v[7]);
        *(u32x4*)(Wt + (size_t)(n0 + lane) * K + k0 + kc * 8) = w; }
    asm volatile("s_waitcnt lgkmcnt(0)" ::: "memory");
}

__device__ __forceinline__ void p0_prologue(const Params& P, LAS unsigned char* lds) {
    int tid_ = threadIdx.x; asm volatile("" : "+v"(tid_)); const int tid = tid_, lane = tid & 63, wid = tid >> 6, G = gridDim.x, bx = blockIdx.x;
    unsigned char* ws = P.ws;
    float* tab = (float*)(ws + WS_TAB);
    if (bx == 0) {
        if (tid < 64) ((unsigned*)(ws + WS_CTL))[tid] = 0u;
        for (int i = tid; i < 3456  ; i += NT) ((unsigned*)(ws + WS_BAR))[i] = 0u;
    }
    if (bx == 1 % G) {
        for (int idx = tid; idx < 8 * 129; idx += NT) { const int h = idx / 129, d = idx % 129; int bk;
            if (d < 16) bk = d; else bk = 15 + (d >= 16) + (d >= 19) + (d >= 21) + (d >= 24) + (d >= 27) + (d >= 31) + (d >= 35) + (d >= 40) + (d >= 46) + (d >= 52) + (d >= 59) + (d >= 67) + (d >= 77) + (d >= 87) + (d >= 99) + (d >= 113);
            tab[h * 132 + d] = P.in[I_REL_BIAS][bk * 8 + h] * LOG2E; }
    }
    if (bx == 2 % G) {
        { const int c = tid & 127, t = tid >> 7;
          const float gv = (t == 0) ? P.in[I_FQN][c] * (0.08838834764831845f * LOG2E) : (t == 1) ? P.in[I_FKN][c] : (t == 2) ? P.in[I_DQN][c & 63] * (0.125f * LOG2E) : P.in[I_DKN][c & 63];
          tab[TAB_GAIN + tid] = gv; }
    }
    if (bx == 3 % G) {
        if (wid == 0) { const float s1 = wave_sum(P.in[I_LQ1][lane] * P.in[I_LK1][lane]), s2 = wave_sum(P.in[I_LQ2][lane] * P.in[I_LK2][lane]);
            if (lane == 0) tab[TAB_LAM] = expf(s1) - expf(s2) + 0.2f; }
        if (wid == 1) { const float gq = wave_max(fmaxf(fabsf(P.in[I_FQN][lane]), fabsf(P.in[I_FQN][lane + 64]))), gk = wave_max(fmaxf(fabsf(P.in[I_FKN][lane]), fabsf(P.in[I_FKN][lane + 64])));
            if (lane == 0) tab[TAB_AQ2] = 2.0f * 128.0f * (0.08838834764831845f * LOG2E) * gq * gk * 1.03f; }
        if (wid == 2) {
            const float gq = wave_max(fabsf(P.in[I_DQN][lane])), gk = wave_max(fabsf(P.in[I_DKN][lane]));
            float bm = 0.f;
            for (int i = lane; i < 256; i += 64) bm = fmaxf(bm, fabsf(P.in[I_REL_BIAS][i]));
            bm = wave_max(bm);
            if (lane == 0) tab[TAB_DBOUND] = 64.0f * (0.125f * LOG2E) * gq * gk * 1.03f + 2.0f * LOG2E * bm; }
        }
    { float* sumsq = (float*)(ws + WS_SUMSQ); for (int i = bx * NT + tid; i < M_; i += G * NT) sumsq[i] = 0.f; }
    { const float* p = P.in[I_P]; bf16_t* pb = (bf16_t*)(ws + WS_PB);
      constexpr int NIT = M_ * PLE / 8; const int st = G * NT; int it = bx * NT + tid;
      for (; it + 3 * st < NIT; it += 4 * st) { f32x4 a[4], b[4];
#pragma unroll
          for (int k = 0; k < 4; ++k) { a[k] = *(const f32x4*)(p + (size_t)(it + k * st) * 8); b[k] = *(const f32x4*)(p + (size_t)(it + k * st) * 8 + 4); }
          asm volatile("" ::: "memory");
#pragma unroll
          for (int k = 0; k < 4; ++k) *(u32x4*)(pb + (size_t)(it + k * st) * 8) = pg8::pack8(a[k], b[k]); }
      for (; it < NIT; it += st) { const f32x4 a = *(const f32x4*)(p + (size_t)it * 8), b = *(const f32x4*)(p + (size_t)it * 8 + 4); *(u32x4*)(pb + (size_t)it * 8) = pg8::pack8(a, b); } }
    { LAS float* mytile = (LAS float*)(lds + wid * (64 * 68 * 4));
      for (int t = bx * 8 + wid; t < 6272; t += G * 8) {
        if (t < 4096) transpose_tile_wave(P.in[I_W_IN], INW, DM, (bf16_t*)(ws + WS_WIN), t & 31, t >> 5, mytile, lane);
        else if (t < 5120) transpose_tile_wave(P.in[I_W_OUT], DM, DM, (bf16_t*)(ws + WS_WOUT), (t - 4096) & 31, (t - 4096) >> 5, mytile, lane);
        else if (t < 6144) transpose_tile_wave(P.in[I_PLE_GATE], DM, DM, (bf16_t*)(ws + WS_WG), (t - 5120) & 31, (t - 5120) >> 5, mytile, lane, P.in[I_PGN]);
        else transpose_tile_wave(P.in[I_PLE_PROJ], DM, PLE, (bf16_t*)(ws + WS_WP), (t - 6144) & 3, (t - 6144) >> 2, mytile, lane);
      } }
    __syncthreads();
    LAS float* wf = (LAS float*)lds;
    { f32x4 t[4][2];
#pragma unroll
      for (int k = 0; k < 4; ++k) { const float* wp = P.in[I_W_IN] + (size_t)(tid + k * NT) * INW + NP; t[k][0] = *(const f32x4*)wp; t[k][1] = *(const f32x4*)(wp + 4); }
#pragma unroll
      for (int k = 0; k < 4; ++k)
#pragma unroll
          for (int j = 0; j < 8; ++j) wf[j * DM + tid + k * NT] = t[k][j >> 2][j & 3]; }
    __syncthreads();
    const float* x = P.in[I_X]; const float* gain = P.in[I_ATTN_NORM]; bf16_t* U = (bf16_t*)(ws + WS_U); float* logf_ = (float*)(ws + WS_LOGF);
    f32x4 gvec[8];
#pragma unroll
    for (int i = 0; i < 8; ++i) gvec[i] = *(const f32x4*)(gain + 256 * i + 4 * lane);
    f32x4 nx[8], nx2[8];
    { const float* xr0 = x + (size_t)(bx * 8 + wid) * DM; const float* xr1 = x + (size_t)((bx + G) * 8 + wid) * DM;
#pragma unroll
      for (int i = 0; i < 8; ++i) nx[i] = *(const f32x4*)(xr0 + 256 * i + 4 * lane);
      if (bx + G < M_ / 8) {
#pragma unroll
        for (int i = 0; i < 8; ++i) nx2[i] = *(const f32x4*)(xr1 + 256 * i + 4 * lane); } }
    for (int rg = bx; rg < M_ / 8; rg += G) {
        const int row = rg * 8 + wid;
        f32x4 y[8]; float ss = 0.f;
#pragma unroll
        for (int i = 0; i < 8; ++i) { y[i] = nx[i]; ss += pg8::dot4(y[i]); nx[i] = nx2[i]; }
        if (rg + 2 * G < M_ / 8) { const float* xn = x + (size_t)((rg + 2 * G) * 8 + wid) * DM;
#pragma unroll
            for (int i = 0; i < 8; ++i) nx2[i] = *(const f32x4*)(xn + 256 * i + 4 * lane); }
        ss = wave_sum(ss);
        const float rstd = 1.0f / sqrtf(ss * (1.0f / 2048.0f) + 1e-6f);
#pragma unroll
        for (int i = 0; i < 8; ++i) { y[i] = y[i] * rstd * gvec[i];
            u32x2 w; w.x = cvt_pk_bf16(y[i][0], y[i][1]); w.y = cvt_pk_bf16(y[i][2], y[i][3]); *(u32x2*)(U + (size_t)row * DM + 256 * i + 4 * lane) = w; }
        float fmine = 0.f;
#pragma unroll 1
        for (int j = 0; j < 8; ++j) { float fa = 0.f;
#pragma unroll
            for (int i = 0; i < 8; ++i) { const f32x4 wv = *(const LAS f32x4*)(wf + j * DM + 256 * i + 4 * lane); fa += (y[i][0] * wv[0] + y[i][1] * wv[1]) + (y[i][2] * wv[2] + y[i][3] * wv[3]); }
            fa = wave_sum(fa);
            fmine = (lane == j) ? fa : fmine; }
        if (lane < 8) { float z = fmine + P.in[I_B_FORGET][lane];
            const float lf = fminf(z, 0.f) - log1pf(expf(-fabsf(z)));
            const int b = row / S_, s = row % S_;
            logf_[(size_t)(b * 8 + lane) * S_ + s] = lf; }
    }
    __syncthreads();
}

__device__ __forceinline__ void cumsum_seq(const Params& P, LAS unsigned char* lds, int seq) {
    int tid_ = threadIdx.x; asm volatile("" : "+v"(tid_)); const int tid = tid_, lane = tid & 63, wid = tid >> 6;
    const float* src = (const float*)(P.ws + WS_LOGF) + (size_t)seq * S_ + tid * 16; float* dst = (float*)(P.ws + WS_C) + (size_t)seq * S_ + tid * 16;
    float v[16];
#pragma unroll
    for (int i = 0; i < 4; ++i) { const f32x4 t = *(const f32x4*)(src + 4 * i); v[4 * i] = t[0]; v[4 * i + 1] = t[1]; v[4 * i + 2] = t[2]; v[4 * i + 3] = t[3]; }
#pragma unroll
    for (int i = 1; i < 16; ++i) v[i] += v[i - 1];
    float tot = v[15], inc = tot;
#pragma unroll
    for (int o = 1; o < 64; o <<= 1) { const float t = __shfl_up(inc, o); if (lane >= o) inc += t; }
    LAS float* wt = (LAS float*)lds;
    if (lane == 63) wt[wid] = inc;
    __syncthreads();
    float pre = inc - tot;
    for (int k = 0; k < wid; ++k) pre += wt[k];
#pragma unroll
    for (int i = 0; i < 4; ++i) { f32x4 t; t[0] = (v[4 * i] + pre) * LOG2E; t[1] = (v[4 * i + 1] + pre) * LOG2E; t[2] = (v[4 * i + 2] + pre) * LOG2E; t[3] = (v[4 * i + 3] + pre) * LOG2E; *(f32x4*)(dst + 4 * i) = t; }
    __syncthreads();
}
#define XB_TMO      128
#define XB_XCNT(j)  (256  + 64 * (j))
#define XB_XSUB(j)  (1280 + 64 * (j))
#define XB_XGEN(j)  (2304 + 64 * (j))
#define XB_TOP      3328
#define XB_TOPGEN   3392
#define XCD_BAR_WORDS 3456
#define XB_SPIN_CAP (1u << 22)

__device__ __forceinline__ unsigned xb_ld(unsigned* p)              { return __hip_atomic_load(p, __ATOMIC_RELAXED, __HIP_MEMORY_SCOPE_AGENT); }
__device__ __forceinline__ unsigned xb_add(unsigned* p, unsigned v) { return __hip_atomic_fetch_add(p, v, __ATOMIC_RELAXED, __HIP_MEMORY_SCOPE_AGENT); }
__device__ __forceinline__ unsigned xb_xcc_id() { return (unsigned)__builtin_amdgcn_s_getreg((3 << 11) | 20) & 0xFu; }
#define XB_SPIN(cond, bar) do { unsigned _sp = 0; while (cond) { __builtin_amdgcn_s_sleep(1); \
    if ((++_sp & 255u) == 0u) { if (xb_ld(&(bar)[XB_TMO])) break; if (_sp > XB_SPIN_CAP) { atomicAdd(&(bar)[XB_TMO], 1u); break; } } } } while (0)

struct XcdBarrier {
    unsigned* bar; unsigned x;
    volatile LAS unsigned* st;
};

__device__ __forceinline__ XcdBarrier xcd_barrier_post(unsigned* bar, volatile LAS unsigned* st) {
    XcdBarrier b; b.bar = bar; b.x = xb_xcc_id(); b.st = st;
    if (threadIdx.x == 0) (void)xb_add(&bar[XB_XCNT(b.x)], 1u);
    return b;
}
__device__ __forceinline__ void xcd_barrier_complete(unsigned* bar, unsigned x, unsigned& nloc, unsigned& nx) {
    const unsigned G = gridDim.x * gridDim.y * gridDim.z;
    unsigned sum, cnt, mine, sp = 0u;
    for (;;) {
        sum = 0u; cnt = 0u; mine = 0u;
#pragma unroll
        for (unsigned j = 0; j < 16; ++j) { const unsigned c = xb_ld(&bar[XB_XCNT(j)]); sum += c; cnt += (c > 0u) ? 1u : 0u; mine = (j == x) ? c : mine; }
        if (sum == G) break;
        __builtin_amdgcn_s_sleep(1);
        if ((++sp & 255u) == 0u) { if (xb_ld(&bar[XB_TMO])) break; if (sp > XB_SPIN_CAP) { atomicAdd(&bar[XB_TMO], 1u); break; } }
    }
    nloc = mine > 0u ? mine : 1u; nx = cnt > 0u ? cnt : 1u;
}

__device__ __forceinline__ void xcd_barrier(const XcdBarrier& b) {
    asm volatile("s_waitcnt vmcnt(0)" ::: "memory");
    __syncthreads();
    if (threadIdx.x == 0) {
        unsigned* bar = b.bar;
        __builtin_amdgcn_s_waitcnt(0);
        unsigned nloc = b.st[0], nx = b.st[1];
        if (nloc == 0u) { xcd_barrier_complete(bar, b.x, nloc, nx); b.st[0] = nloc; b.st[1] = nx; }
        const unsigned old = xb_add(&bar[XB_XSUB(b.x)], 1u);
        const unsigned gen = old / nloc;
        if (old + 1u == (gen + 1u) * nloc) {
            __builtin_amdgcn_fence(__ATOMIC_RELEASE, "agent");
            asm volatile("s_waitcnt vmcnt(0)" ::: "memory");
            const unsigned og = xb_add(&bar[XB_TOP], 1u);
            const unsigned tg = og / nx;
            if (og + 1u == (tg + 1u) * nx) xb_add(&bar[XB_TOPGEN], 1u);
            else XB_SPIN(xb_ld(&bar[XB_TOPGEN]) == tg, bar);
            __builtin_amdgcn_fence(__ATOMIC_ACQUIRE, "agent");
            xb_add(&bar[XB_XGEN(b.x)], 1u);
            asm volatile("s_waitcnt vmcnt(0)" ::: "memory");
        } else {
            XB_SPIN(xb_ld(&bar[XB_XGEN(b.x)]) == gen, bar);
            __builtin_amdgcn_fence(__ATOMIC_ACQUIRE, "agent");
            asm volatile("s_waitcnt vmcnt(0)" ::: "memory");
        }
    }
    __syncthreads();
}


#define MFMA32(a, b, c) __builtin_amdgcn_mfma_f32_32x32x16_bf16((a), (b), (c), 0, 0, 0)
constexpr int AL_NBUF = 4, AL_PD = 3, AL_CLS = 131072, AL_MISC = AL_CLS + 8192, AL_BIAS = AL_MISC + 256;
#define ATT_WAITV(n) asm volatile("s_waitcnt vmcnt(" #n ")" ::: "memory")

template <bool ONLINE, int NO>
__device__ __forceinline__ void softmax_tile(f32x16 (&s)[2], float& m, float& l, f32x16 (&O)[NO], u32x4 (&pk)[4]) {
    float mn = 0.f;
    if (ONLINE) {
        float mx = s[0][0];
#pragma unroll
        for (int i = 1; i < 16; ++i) mx = fmaxf(mx, s[0][i]);
#pragma unroll
        for (int i = 0; i < 16; ++i) mx = fmaxf(mx, s[1][i]);
        mx = fmaxf(mx, __shfl_xor(mx, 32));
        mn = fmaxf(m, mx);
        if (__builtin_amdgcn_ballot_w64(mn > m) != 0ull) {
            const float alpha = __builtin_amdgcn_exp2f(m - mn);
            m = mn; l *= alpha;
#pragma unroll
            for (int d = 0; d < NO; ++d) O[d] = O[d] * alpha;
        }
    }
    float ps = 0.f;
#pragma unroll
    for (int blk = 0; blk < 2; ++blk)
#pragma unroll
        for (int i = 0; i < 16; ++i) { const float p = __builtin_amdgcn_exp2f(ONLINE ? (s[blk][i] - mn) : s[blk][i]); ps += p; s[blk][i] = p; }
    l += ps;
#pragma unroll
    for (int blk = 0; blk < 2; ++blk)
#pragma unroll
        for (int sh = 0; sh < 2; ++sh) { u32x4 pw;
            pw.x = cvt_pk_bf16(s[blk][8 * sh], s[blk][8 * sh + 1]); pw.y = cvt_pk_bf16(s[blk][8 * sh + 2], s[blk][8 * sh + 3]);
            pw.z = cvt_pk_bf16(s[blk][8 * sh + 4], s[blk][8 * sh + 5]); pw.w = cvt_pk_bf16(s[blk][8 * sh + 6], s[blk][8 * sh + 7]); pk[2 * blk + sh] = pw; }
}


template <int G>
__device__ __forceinline__ void v_issue(s16x4 (&v)[8], const unsigned addr) {
    asm volatile("ds_read_b64_tr_b16 %0, %8 offset:%9\n\tds_read_b64_tr_b16 %1, %8 offset:%10\n\tds_read_b64_tr_b16 %2, %8 offset:%11\n\tds_read_b64_tr_b16 %3, %8 offset:%12\n\t"
                 "ds_read_b64_tr_b16 %4, %8 offset:%13\n\tds_read_b64_tr_b16 %5, %8 offset:%14\n\tds_read_b64_tr_b16 %6, %8 offset:%15\n\tds_read_b64_tr_b16 %7, %8 offset:%16"
                 : "=&v"(v[0]), "=&v"(v[1]), "=&v"(v[2]), "=&v"(v[3]), "=&v"(v[4]), "=&v"(v[5]), "=&v"(v[6]), "=&v"(v[7])
                 : "v"(addr), "i"(G * 4096), "i"(G * 4096 + 256), "i"(G * 4096 + 512), "i"(G * 4096 + 768), "i"(G * 4096 + 1024), "i"(G * 4096 + 1280), "i"(G * 4096 + 1536), "i"(G * 4096 + 1792));
}
template <int N>
__device__ __forceinline__ void v_wait(s16x4 (&v)[8]) {
    asm volatile("s_waitcnt lgkmcnt(%8)" : "+v"(v[0]), "+v"(v[1]), "+v"(v[2]), "+v"(v[3]), "+v"(v[4]), "+v"(v[5]), "+v"(v[6]), "+v"(v[7]) : "i"(N));
}
__device__ __forceinline__ void k_issue4(bf16x8 (&k)[8], const unsigned a0, const unsigned a1, const unsigned a2, const unsigned a3) {
    asm volatile("ds_read_b128 %0, %8\n\tds_read_b128 %1, %8 offset:8192\n\tds_read_b128 %2, %9\n\tds_read_b128 %3, %9 offset:8192\n\t"
                 "ds_read_b128 %4, %10\n\tds_read_b128 %5, %10 offset:8192\n\tds_read_b128 %6, %11\n\tds_read_b128 %7, %11 offset:8192"
                 : "=&v"(k[0]), "=&v"(k[1]), "=&v"(k[2]), "=&v"(k[3]), "=&v"(k[4]), "=&v"(k[5]), "=&v"(k[6]), "=&v"(k[7])
                 : "v"(a0), "v"(a1), "v"(a2), "v"(a3));
}
template <int N>
__device__ __forceinline__ void k_wait(bf16x8 (&k)[8]) {
    asm volatile("s_waitcnt lgkmcnt(%8)" : "+v"(k[0]), "+v"(k[1]), "+v"(k[2]), "+v"(k[3]), "+v"(k[4]), "+v"(k[5]), "+v"(k[6]), "+v"(k[7]) : "i"(N));
}
#define ATT_PV(v_, p_) do { const bf16x8 pf_ = __builtin_bit_cast(bf16x8, (p_)); _Pragma("unroll") for (int d = 0; d < 4; ++d) { \
        const bf16x8 vf_ = __builtin_shufflevector((v_)[2 * d], (v_)[2 * d + 1], 0, 1, 2, 3, 4, 5, 6, 7); O[d] = MFMA32(vf_, pf_, O[d]); } } while (0)

template <int MODE>
__device__ __forceinline__ void attn_unit(const Params& P, LAS unsigned char* lds, const int b, const int h, const int qb) {
    constexpr bool FOX = (MODE == 0), ONLINE = (MODE != 1);
    constexpr int ROWS = FOX ? 256 : 128, NQ = FOX ? 8 : 4;
    int tid_ = threadIdx.x; asm volatile("" : "+v"(tid_));
    const int tid = tid_, lane = tid & 63, w = __builtin_amdgcn_readfirstlane(tid >> 6), r = lane & 31, hh = lane >> 5;
    const int mp = FOX ? 0 : (w >> 2);
    const int q0 = qb * ROWS, q0w = q0 + 32 * (FOX ? w : (w & 3)), q = q0w + r;
    bf16_t* QKVZ = (bf16_t*)(P.ws + WS_QKVZ);
    const float* tab = (const float*)(P.ws + WS_TAB);
    const size_t tokbase = (size_t)b * S_;
    const int colO = FOX ? h * 128 : 1024 + h * 128;
    constexpr size_t TS = (size_t)4 * 8 * 8192 * 128;
    const size_t hb = ((size_t)(b * 8 + h)) * 8192 * 128;
    const bf16_t* Qb = QKVZ + (FOX ? 0 : 4) * TS + hb; const bf16_t* Kb_ = QKVZ + (FOX ? 1 : 5) * TS + hb;
    const bf16_t* Vb_ = QKVZ + (FOX ? 2 : 6) * TS + hb; const bf16_t* Zb = QKVZ + (FOX ? 3 : 7) * TS + hb;
    constexpr int RS = 128;
    bf16x8 Qf[NQ];
    { const bf16_t* qp = Qb + (size_t)q * RS + (FOX ? 0 : 64 * mp) + 8 * hh;
#pragma unroll
      for (int ks = 0; ks < NQ; ++ks) Qf[ks] = *(const bf16x8*)(qp + 16 * ks); }
    const int nt = (q0 + ROWS) / 64;
    int kt0 = 0;
    const float* Cl = (const float*)(P.ws + WS_C) + (size_t)(b * 8 + h) * S_;
    if (FOX) {
        const int kd = q0 / 64; int pred = 0;
        if (tid < kd) pred = (tab[TAB_AQ2] + Cl[q0] - Cl[tid * 64 + 63] >= -150.0f) ? 1 : 0;
        kt0 = kd - __syncthreads_count(pred);
    } else {
        if (tid < 129) ((LAS float*)(lds + AL_BIAS))[tid] = tab[h * 132 + tid] - tab[h * 132 + 128];
    }
    const int krow = 4 * w + (lane >> 4), kchunk = (lane & 15) ^ (krow & 15);
    const bf16_t* kg = Kb_ + (size_t)krow * RS + kchunk * 8;
    const int vst = 2 * w + (lane >> 5), vkey = (vst >> 2) * 8 + ((lane >> 2) & 7);
    const bf16_t* vg = Vb_ + (size_t)vkey * RS + (vst & 3) * 32 + (lane & 3) * 8;
    const float* cg_ = Cl + lane;
#define ATT_DMA(kt_, buf_) do { const size_t ro_ = (size_t)((kt_) * 64) * RS; LAS unsigned char* b_ = lds + (buf_) * 32768 + w * 1024; \
        __builtin_amdgcn_global_load_lds((const unsigned*)(kg + ro_), (LAS unsigned*)(b_), 16, 0, 0); \
        __builtin_amdgcn_global_load_lds((const unsigned*)(kg + ro_ + (size_t)32 * RS), (LAS unsigned*)(b_ + 8192), 16, 0, 0); \
        __builtin_amdgcn_global_load_lds((const unsigned*)(vg + ro_), (LAS unsigned*)(b_ + 16384), 16, 0, 0); \
        __builtin_amdgcn_global_load_lds((const unsigned*)(vg + ro_ + (size_t)32 * RS), (LAS unsigned*)(b_ + 16384 + 8192), 16, 0, 0); \
        if (FOX) __builtin_amdgcn_global_load_lds((const unsigned*)(cg_ + (kt_) * 64), (LAS unsigned*)(lds + AL_CLS + ((buf_) * 8 + w) * 256), 4, 0, 0); } while (0)
    const int pr = (r & 19) | ((r & 4) << 1) | ((r & 8) >> 1);
    const unsigned kra = pr * 256, kswz = pr & 15;
    const unsigned vra = 16384 + hh * 2048 + ((lane & 15) >> 2) * 64 + ((lane >> 4) & 1) * 32 + (lane & 3) * 8;
    f32x16 O[4];
#pragma unroll
    for (int d = 0; d < 4; ++d)
#pragma unroll
        for (int i = 0; i < 16; ++i) O[d][i] = 0.f;
    float m1 = ONLINE ? -INFINITY : 0.f, l1 = 0.f;
    const int ktw_last = (q0w + 31) / 64;

    ATT_WAITV(0); __builtin_amdgcn_s_barrier(); asm volatile("" ::: "memory");
#pragma unroll
    for (int i = 0; i < AL_PD; ++i) if (kt0 + i < nt) ATT_DMA(kt0 + i, i);
    for (int kt = kt0; kt < nt; ++kt) {
        const int rel = kt - kt0, cur = rel & (AL_NBUF - 1);
        if (kt + 2 < nt) { if (FOX) ATT_WAITV(10); else ATT_WAITV(8); } else if (kt + 1 < nt) { if (FOX) ATT_WAITV(5); else ATT_WAITV(4); } else ATT_WAITV(0);
        __builtin_amdgcn_s_barrier(); asm volatile("" ::: "memory");
        if (kt + AL_PD < nt) ATT_DMA(kt + AL_PD, (rel + AL_PD) & (AL_NBUF - 1));
        if (kt <= ktw_last) {
            const LAS unsigned char* Kb = lds + cur * 32768;
            const int kbase = kt * 64 + 8 * hh;
            u32x4 pk1[4];
            f32x16 s[2];
#pragma unroll
            for (int i = 0; i < 16; ++i) { s[0][i] = 0.f; s[1][i] = 0.f; }
            s16x4 va[8], vb[8], vc[8], vd[8];
            const unsigned vaddr = (unsigned)(uintptr_t)(Kb + vra);
            if constexpr (MODE == 1) {
                bf16x8 kf[8];
                const unsigned kb_ = (unsigned)(uintptr_t)Kb + kra, c0 = mp * 8 + hh;
                k_issue4(kf, kb_ + (((c0) ^ kswz) << 4), kb_ + (((c0 + 2) ^ kswz) << 4), kb_ + (((c0 + 4) ^ kswz) << 4), kb_ + (((c0 + 6) ^ kswz) << 4));
                v_issue<0>(va, vaddr);
                k_wait<8>(kf);
#pragma unroll
                for (int ks = 0; ks < 4; ++ks) { s[0] = MFMA32(kf[2 * ks], Qf[ks], s[0]); s[1] = MFMA32(kf[2 * ks + 1], Qf[ks], s[1]); }
                v_issue<1>(vb, vaddr);
            } else {
#pragma unroll
            for (int ks = 0; ks < NQ; ++ks) {
                const unsigned chunk = mp * 8 + 2 * ks + hh;
                const unsigned off = kra + ((chunk ^ kswz) << 4);
                const bf16x8 a0 = *(const LAS bf16x8*)(Kb + off), a1 = *(const LAS bf16x8*)(Kb + off + 8192);
                s[0] = MFMA32(a0, Qf[ks], s[0]); s[1] = MFMA32(a1, Qf[ks], s[1]);
            }
            v_issue<0>(va, vaddr);
            }
            if (FOX) {
                const LAS float* cl = (const LAS float*)(lds + AL_CLS + (cur * 8 + w) * 256) + 8 * hh;
#pragma unroll
                for (int blk = 0; blk < 2; ++blk)
#pragma unroll
                    for (int j4 = 0; j4 < 4; ++j4) { const f32x4 c = *(const LAS f32x4*)(cl + 32 * blk + 16 * (j4 >> 1) + 4 * (j4 & 1));
#pragma unroll
                        for (int e = 0; e < 4; ++e) s[blk][4 * j4 + e] -= c[e]; }
            } else if (q0w - kt * 64 - 63 < 128) {
                const LAS float* bl = (const LAS float*)(lds + AL_BIAS);
#pragma unroll
                for (int blk = 0; blk < 2; ++blk)
#pragma unroll
                    for (int i = 0; i < 16; ++i) { const int dist = q - (kbase + 32 * blk + 16 * (i >> 3) + (i & 7)); const int di = dist < 0 ? 0 : (dist > 128 ? 128 : dist); s[blk][i] += bl[di]; }
            }
            if (kt * 64 + 63 > q0w) {
#pragma unroll
                for (int blk = 0; blk < 2; ++blk)
#pragma unroll
                    for (int i = 0; i < 16; ++i) { if (kbase + 32 * blk + 16 * (i >> 3) + (i & 7) > q) s[blk][i] = -INFINITY; }
            }
            softmax_tile<ONLINE, 4>(s, m1, l1, O, pk1);
            if constexpr (MODE == 1) {
                v_issue<2>(vc, vaddr); v_wait<15>(va); ATT_PV(va, pk1[0]); v_issue<3>(vd, vaddr); v_wait<15>(vb); ATT_PV(vb, pk1[1]); v_wait<8>(vc); ATT_PV(vc, pk1[2]); v_wait<0>(vd); ATT_PV(vd, pk1[3]);
            } else {
            v_issue<1>(vb, vaddr); v_wait<8>(va); ATT_PV(va, pk1[0]);
            v_issue<2>(va, vaddr); v_wait<8>(vb); ATT_PV(vb, pk1[1]);
            v_issue<3>(vb, vaddr); v_wait<8>(va); ATT_PV(va, pk1[2]);
            v_wait<0>(vb); ATT_PV(vb, pk1[3]);
            }
        }
    }
#undef ATT_DMA
    bf16_t* mix = (bf16_t*)(P.ws + WS_MIX) + (tokbase + q) * DM + colO;
    const bf16_t* zp = Zb + (size_t)q * RS;
    const float inv1 = 1.0f / (l1 + __shfl_xor(l1, 32));
    u32x2 zv[4][4]; f32x4 gv[4][4];
    if (FOX || mp == 0) {
#pragma unroll
        for (int d = 0; d < 4; ++d)
#pragma unroll
            for (int a = 0; a < 4; ++a) { const int d0 = 32 * d + 8 * a + 4 * hh; zv[d][a] = *(const u32x2*)(zp + d0); if (!FOX) gv[d][a] = *(const f32x4*)(P.in[I_DON] + d0); }
    }
    asm volatile("" ::: "memory");
    if (FOX) {
#pragma unroll
        for (int d = 0; d < 4; ++d)
#pragma unroll
            for (int a = 0; a < 4; ++a) { const int d0 = 32 * d + 8 * a + 4 * hh; const u32x2 z2 = zv[d][a];
                const float o0 = O[d][4 * a] * inv1 * silu_f(bf_lo(z2.x)), o1 = O[d][4 * a + 1] * inv1 * silu_f(bf_hi(z2.x));
                const float o2 = O[d][4 * a + 2] * inv1 * silu_f(bf_lo(z2.y)), o3 = O[d][4 * a + 3] * inv1 * silu_f(bf_hi(z2.y));
                u32x2 ov; ov.x = cvt_pk_bf16(o0, o1); ov.y = cvt_pk_bf16(o2, o3); *(u32x2*)(mix + d0) = ov; }
        __syncthreads();
    } else {
        __syncthreads();
        LAS float* xb = (LAS float*)lds;
        if (mp == 1) {
#pragma unroll
            for (int d = 0; d < 4; ++d)
#pragma unroll
                for (int i = 0; i < 16; ++i) xb[(((w & 3) * 4 + d) * 16 + i) * 64 + lane] = O[d][i] * inv1;
        }
        __syncthreads();
        if (mp == 0) {
            const float lam = tab[TAB_LAM]; float ss = 0.f;
#pragma unroll
            for (int d = 0; d < 4; ++d)
#pragma unroll
                for (int i = 0; i < 16; ++i) { const float o = O[d][i] * inv1 - lam * xb[((w * 4 + d) * 16 + i) * 64 + lane]; O[d][i] = o; ss += o * o; }
            ss += __shfl_xor(ss, 32);
            const float rstd = 0.8f * __builtin_amdgcn_rsqf(ss * (1.0f / 128.0f) + 1e-6f);
#pragma unroll
            for (int d = 0; d < 4; ++d)
#pragma unroll
                for (int a = 0; a < 4; ++a) { const int d0 = 32 * d + 8 * a + 4 * hh; const u32x2 z2 = zv[d][a]; const f32x4 g = gv[d][a];
                    const float o0 = O[d][4 * a] * rstd * g[0] * silu_f(bf_lo(z2.x)), o1 = O[d][4 * a + 1] * rstd * g[1] * silu_f(bf_hi(z2.x));
                    const float o2 = O[d][4 * a + 2] * rstd * g[2] * silu_f(bf_lo(z2.y)), o3 = O[d][4 * a + 3] * rstd * g[3] * silu_f(bf_hi(z2.y));
                    u32x2 ov; ov.x = cvt_pk_bf16(o0, o1); ov.y = cvt_pk_bf16(o2, o3); *(u32x2*)(mix + d0) = ov; }
        }
        __syncthreads();
    }
}

__device__ __forceinline__ void attn_phase(const Params& P, LAS unsigned char* lds) {
    int tid_ = threadIdx.x; asm volatile("" : "+v"(tid_)); const int tid = tid_;
    unsigned* ctr = (unsigned*)(P.ws + WS_CTL);
    LAS int* misc = (LAS int*)(lds + AL_MISC);
    const int xq = (int)(__builtin_amdgcn_s_getreg((3 << 11) | 20) & 7u);
    const bool bounded = ((const float*)(P.ws + WS_TAB))[TAB_DBOUND] <= 60.0f;
    for (;;) {
        if (tid == 0) { int u = -1;
            for (int k = 0; k < 8; ++k) { const int qi = (xq + k) & 7; const unsigned v = atomicAdd(ctr + qi, 1u); if (v < (unsigned)QN) { u = qi * QN + (int)v; break; } }
            misc[0] = u; }
        __syncthreads();
        const int u = misc[0];
        __syncthreads();
        if (u < 0) break;
        const int qi = u / QN, v = u % QN;
        if (v < 256) { const int bh = qi * 4 + (v >> 6), qb = 63 - (v & 63); if (bounded) attn_unit<1>(P, lds, bh >> 3, bh & 7, qb); else attn_unit<2>(P, lds, bh >> 3, bh & 7, qb); }
        else { const int v2 = v - 256; const int bh = qi * 4 + (v2 >> 5), qb = 31 - (v2 & 31); attn_unit<0>(P, lds, bh >> 3, bh & 7, qb); }
    }
}

__global__ void __launch_bounds__(NT, 2) hymba_fwd(Params P) {
    extern __shared__ __attribute__((aligned(16))) unsigned char lds_raw[];
    LAS unsigned char* lds = (LAS unsigned char*)lds_raw;
    cg::grid_group grid = cg::this_grid();
    unsigned char* ws = P.ws;
    const int G = gridDim.x, bx = blockIdx.x;

    volatile LAS unsigned* xst = (volatile LAS unsigned*)(lds + LDS_BYTES - 16);
    if (threadIdx.x < 2) xst[threadIdx.x] = 0u;
    __syncthreads();

    p0_prologue(P, lds);
    grid.sync();
    const XcdBarrier xbar = xcd_barrier_post((unsigned*)(ws + WS_BAR), xst);

    {
        pg8::Gemm g{(const bf16_t*)(ws + WS_U), (const bf16_t*)(ws + WS_WIN), M_, NP, DM}; pg8::StaticOrder S; S.init(M_, NP, G, bx);
        pg8::EpiProj E{(bf16_t*)(ws + WS_QKVZ), (const float*)(ws + WS_TAB) + TAB_GAIN, (LAS float*)(lds + pg8::STAGE_BYTES)};
        pg8::gemm_phase<pg8::EpiProj, pg8::StaticOrder, true, true>(lds, g, S, E);
    }
    {
        pg8::Gemm g{(const bf16_t*)(ws + WS_PB), (const bf16_t*)(ws + WS_WP), M_, DM, PLE}; pg8::StaticOrder S; S.init(M_, DM, G, bx);
        pg8::EpiPlain E{(bf16_t*)(ws + WS_E), DM};
        pg8::gemm_phase<pg8::EpiPlain, pg8::StaticOrder, true, true>(lds, g, S, E);
    }
    if (bx < 32) cumsum_seq(P, lds, bx);
    xcd_barrier(xbar);

    attn_phase(P, lds);
    xcd_barrier(xbar);

    {
        pg8::Gemm g{(const bf16_t*)(ws + WS_MIX), (const bf16_t*)(ws + WS_WOUT), M_, DM, DM}; pg8::StaticOrder S; S.init(M_, DM, G, bx);
        pg8::EpiOut E{P.in[I_X], (bf16_t*)(ws + WS_A2), (float*)(ws + WS_SUMSQ)};
        pg8::gemm_phase<pg8::EpiOut, pg8::StaticOrder, true, true>(lds, g, S, E);
    }
    xcd_barrier(xbar);
    {
        pg8::Gemm g{(const bf16_t*)(ws + WS_A2), (const bf16_t*)(ws + WS_WG), M_, DM, DM}; pg8::StaticOrder S; S.init(M_, DM, G, bx);
        pg8::EpiGate E{P.out, (const bf16_t*)(ws + WS_A2), (const bf16_t*)(ws + WS_E), (const float*)(ws + WS_SUMSQ)};
        pg8::gemm_phase<pg8::EpiGate, pg8::StaticOrder, true, true>(lds, g, S, E);
    }
}

extern "C" void kernel_launch(void* const* d_in, const int* in_sizes, int n_in, void* d_out, int out_size, void* d_ws, size_t ws_size, hipStream_t stream) {
    static int grid = 0;
    if (grid == 0) {
        if (n_in != 19 || out_size != M_ * DM || ws_size < WS_TOTAL) { fprintf(stderr, "kernel_launch: unexpected shapes (n_in %d, out %d, ws %zu < %zu)\n", n_in, out_size, ws_size, (size_t)WS_TOTAL); grid = -1; return; }
        int dev = 0, cus = 0, per_cu = 0;
        hipGetDevice(&dev); hipDeviceGetAttribute(&cus, hipDeviceAttributeMultiprocessorCount, dev);
        if (hipFuncSetAttribute((const void*)hymba_fwd, hipFuncAttributeMaxDynamicSharedMemorySize, LDS_BYTES) != hipSuccess) { fprintf(stderr, "kernel_launch: hipFuncSetAttribute failed\n"); grid = -1; return; }
        if (hipOccupancyMaxActiveBlocksPerMultiprocessor(&per_cu, (const void*)hymba_fwd, NT, LDS_BYTES) != hipSuccess || per_cu < 1) { fprintf(stderr, "kernel_launch: occupancy query gives %d\n", per_cu); per_cu = 1; }
        (void)hipGetLastError();
        grid = cus * (per_cu > 1 ? 1 : per_cu);
    }
    if (grid < 0) return;
    Params p{};
    for (int i = 0; i < 19; ++i) p.in[i] = (const float*)d_in[i];
    p.out = (float*)d_out; p.ws = (unsigned char*)d_ws;
    void* args[] = {&p};
    const hipError_t e = hipLaunchCooperativeKernel((const void*)hymba_fwd, dim3(grid), dim3(NT), args, LDS_BYTES, stream);
    if (e != hipSuccess) fprintf(stderr, "kernel_launch: cooperative launch failed: %s (grid %d)\n", hipGetErrorString(e), grid);
}
```

```cpp
#include <hip/hip_runtime.h>
#include <hip/hip_cooperative_groups.h>
#include <cstdio>
#include <cstdint>
namespace cg = cooperative_groups;

constexpr float LOG2E = 1.4426950408889634f;
namespace pg8 {
#define PG8_LAS __attribute__((address_space(3)))
typedef unsigned short bf16_t;
typedef short bf16x8 __attribute__((ext_vector_type(8)));
typedef float f32x4 __attribute__((ext_vector_type(4)));
typedef unsigned u32x4 __attribute__((ext_vector_type(4)));
constexpr int BM = 256, BK = 64, HALF = 128, HTB = HALF * BK * 2  , STAGE_BYTES = 8 * HTB, NXCD = 8, WGM = 2;

__host__ __device__ __forceinline__ int lds_byte(int r, int c) { const int st = (r >> 4) * 2 + (c >> 5), rr = r & 15, cc = c & 31, ob = rr * 64 + cc * 2; return st * 1024 + (ob ^ (((ob >> 9) & 1) << 5)); }
__host__ __device__ __forceinline__ void stage_rc(int b, int& R, int& C) { const int st = b / 1024, sb = b % 1024, swz = sb ^ (((sb >> 9) & 1) << 5); R = (st >> 1) * 16 + swz / 64; C = (st & 1) * 32 + (swz % 64) / 2; }
__host__ __device__ __forceinline__ int perm32(int rho) { const int n = rho >> 4, i = rho & 15; return 8 * (i >> 2) + 4 * n + (i & 3); }

struct Unit { int pm, pn; };
struct Gemm { const bf16_t* A; const bf16_t* Bt; int M, N, K; };

struct StaticOrder {
    int nM, nN, nwg, G, c;
    __host__ __device__ void init(int M, int N, int G_, int c_) { nM = M / BM; nN = N / BM; nwg = nM * nN; G = G_; c = c_; }
    __host__ __device__ bool next(int i, Unit& u) const {
        const long L = (long)i * G + c; if (L >= nwg) return false;
        int wgid = (int)L; { const int q = nwg / NXCD, r = nwg % NXCD, xcd = wgid % NXCD, off = wgid / NXCD; wgid = (xcd < r ? xcd * (q + 1) : r * (q + 1) + (xcd - r) * q) + off; }
        const int nig = WGM * nN, gid = wgid / nig, fm = gid * WGM, gsz = (nM - fm) < WGM ? (nM - fm) : WGM;
        u.pm = fm + ((wgid % nig) % gsz); u.pn = (wgid % nig) / gsz; return true;
    }
    __device__ __forceinline__ void a_ready(const Unit&) const {}
    __device__ __forceinline__ void done(const Unit&) const {}
};

__device__ __forceinline__ unsigned cvt_pk_bf16(float lo, float hi) {
    typedef __bf16 bf2_t __attribute__((ext_vector_type(2))); typedef float f2_t __attribute__((ext_vector_type(2)));
    f2_t v = {lo, hi}; return __builtin_bit_cast(unsigned, __builtin_convertvector(v, bf2_t));
}
__device__ __forceinline__ u32x4 pack8(const f32x4 a, const f32x4 b) { u32x4 w; w.x = cvt_pk_bf16(a[0], a[1]); w.y = cvt_pk_bf16(a[2], a[3]); w.z = cvt_pk_bf16(b[0], b[1]); w.w = cvt_pk_bf16(b[2], b[3]); return w; }
__device__ __forceinline__ float dot4(const f32x4 a) { return (a[0] * a[0] + a[1] * a[1]) + (a[2] * a[2] + a[3] * a[3]); }

struct EpiPlain {
    static constexpr bool PERM = true, AFTER_DRAIN = false;
    bf16_t* O; int ldc;
    __device__ __forceinline__ void operator()(const f32x4 (&acc)[2][2][4][2], const Unit& u, int wr, int wc, int fr, int fq) const {
        const int row0 = u.pm * BM + wr * 64 + fr, col0 = u.pn * BM + wc * 32 + 8 * fq;
#pragma unroll
        for (int ai = 0; ai < 2; ++ai)
#pragma unroll
            for (int m = 0; m < 4; ++m) { bf16_t* rowp = O + (size_t)(row0 + ai * HALF + m * 16) * ldc + col0;
#pragma unroll
                for (int bj = 0; bj < 2; ++bj) *(u32x4*)(rowp + bj * HALF) = pack8(acc[ai][bj][m][0], acc[ai][bj][m][1]); }
    }
};

struct EpiProj {
    static constexpr bool PERM = true, AFTER_DRAIN = false;
    bf16_t* O; const float* gtab; PG8_LAS float* red;
    __device__ __forceinline__ void operator()(const f32x4 (&acc)[2][2][4][2], const Unit& u, int wr, int wc, int fr, int fq) const {
        const int type = u.pn >> 2;
        const int row0 = u.pm * BM + wr * 64 + fr;
        bf16_t* const Ot = O + (((size_t)type * 4 + (size_t)(u.pm >> 5)) * 8 + (size_t)((u.pn & 3) * 2)) * 8192 * 128 + (size_t)(u.pm & 31) * 256 * 128;
        unsigned char* const Ot1 = (unsigned char*)(Ot + (size_t)8192 * 128);
        const unsigned voff = (unsigned)(((wr * 64 + fr) * 128 + wc * 32 + 8 * fq) * 2);
        const bool isnorm = (type == 0) || (type == 1) || (type == 4) || (type == 5);
        if (!isnorm) {
#pragma unroll
            for (int ai = 0; ai < 2; ++ai)
#pragma unroll
                for (int m = 0; m < 4; ++m) { const unsigned vo = voff + (unsigned)((ai * HALF + m * 16) * 256);
                    *(u32x4*)((unsigned char*)Ot + vo) = pack8(acc[ai][0][m][0], acc[ai][0][m][1]); *(u32x4*)(Ot1 + vo) = pack8(acc[ai][1][m][0], acc[ai][1][m][1]); }
        } else {
            const bool isdiff = type >= 4;
#pragma unroll
            for (int ai = 0; ai < 2; ++ai)
#pragma unroll
                for (int m = 0; m < 4; ++m)
#pragma unroll
                    for (int bj = 0; bj < 2; ++bj) {
                        float s = dot4(acc[ai][bj][m][0]) + dot4(acc[ai][bj][m][1]);
                        s += __shfl_xor(s, 16); s += __shfl_xor(s, 32);
                        if (fq == 0) red[(ai * HALF + wr * 64 + m * 16 + fr) * 8 + bj * 4 + wc] = s;
                    }
            asm volatile("s_waitcnt lgkmcnt(0)" ::: "memory"); __builtin_amdgcn_s_barrier(); asm volatile("" ::: "memory");
            const float* gp = gtab + ((type & 1) + ((type >> 2) << 1)) * 128 + wc * 32 + 8 * fq;
            const f32x4 g0 = *(const f32x4*)(gp), g1 = *(const f32x4*)(gp + 4);
            const float invn = isdiff ? (1.0f / 64.0f) : (1.0f / 128.0f);
#pragma unroll
            for (int ai = 0; ai < 2; ++ai)
#pragma unroll
                for (int m = 0; m < 4; ++m) { const int rl = ai * HALF + wr * 64 + m * 16 + fr; const unsigned vo = voff + (unsigned)((ai * HALF + m * 16) * 256);
#pragma unroll
                    for (int bj = 0; bj < 2; ++bj) {
                        const f32x4 pr = *(const PG8_LAS f32x4*)(red + rl * 8 + bj * 4);
                        const float ss = isdiff ? ((wc < 2) ? (pr[0] + pr[1]) : (pr[2] + pr[3])) : ((pr[0] + pr[1]) + (pr[2] + pr[3]));
                        const float rstd = __builtin_amdgcn_rsqf(ss * invn + 1e-6f);
                        *(u32x4*)((bj ? Ot1 : (unsigned char*)Ot) + vo) = pack8(acc[ai][bj][m][0] * g0 * rstd, acc[ai][bj][m][1] * g1 * rstd);
                    } }
        }
    }
};

struct EpiOut {
    static constexpr bool PERM = true, AFTER_DRAIN = false;
    const float* x; bf16_t* a2; float* sumsq;
    __device__ __forceinline__ void operator()(const f32x4 (&acc)[2][2][4][2], const Unit& u, int wr, int wc, int fr, int fq) const {
        const int row0 = u.pm * BM + wr * 64 + fr, col0 = u.pn * BM + wc * 32 + 8 * fq;
#pragma unroll
        for (int ai = 0; ai < 2; ++ai) {
            f32x4 xr[4][2][2];
#pragma unroll
            for (int m = 0; m < 4; ++m)
#pragma unroll
                for (int bj = 0; bj < 2; ++bj) { const size_t off = (size_t)(row0 + ai * HALF + m * 16) * 2048 + col0 + bj * HALF;
                    xr[m][bj][0] = *(const f32x4*)(x + off); xr[m][bj][1] = *(const f32x4*)(x + off + 4); }
            asm volatile("" ::: "memory");
#pragma unroll
            for (int m = 0; m < 4; ++m) { const int row = row0 + ai * HALF + m * 16; float ss = 0.f;
#pragma unroll
                for (int bj = 0; bj < 2; ++bj) { const size_t off = (size_t)row * 2048 + col0 + bj * HALF;
                    const f32x4 h0 = xr[m][bj][0] + acc[ai][bj][m][0], h1 = xr[m][bj][1] + acc[ai][bj][m][1];
                    ss += dot4(h0) + dot4(h1);
                    *(u32x4*)(a2 + off) = pack8(h0, h1); }
                ss += __shfl_xor(ss, 16); ss += __shfl_xor(ss, 32);
                if (fq == 0) atomicAdd(sumsq + row, ss); }
        }
    }
};

struct EpiGate {
    static constexpr bool PERM = true, AFTER_DRAIN = false;
    float* out; const bf16_t* h; const bf16_t* e; const float* sumsq;
    __device__ __forceinline__ void operator()(const f32x4 (&acc)[2][2][4][2], const Unit& u, int wr, int wc, int fr, int fq) const {
        const int row0 = u.pm * BM + wr * 64 + fr, col0 = u.pn * BM + wc * 32 + 8 * fq;
#pragma unroll
        for (int ai = 0; ai < 2; ++ai) {
            u32x4 hv[4][2], ev[4][2]; float sq[4];
#pragma unroll
            for (int m = 0; m < 4; ++m) { const int row = row0 + ai * HALF + m * 16; sq[m] = sumsq[row];
#pragma unroll
                for (int bj = 0; bj < 2; ++bj) { const size_t off = (size_t)row * 2048 + col0 + bj * HALF; hv[m][bj] = *(const u32x4*)(h + off); ev[m][bj] = *(const u32x4*)(e + off); } }
            asm volatile("" ::: "memory");
#pragma unroll
            for (int m = 0; m < 4; ++m) { const int row = row0 + ai * HALF + m * 16;
                const float nr = -LOG2E * __builtin_amdgcn_rsqf(sq[m] * (1.0f / 2048.0f) + 1e-6f);
#pragma unroll
                for (int bj = 0; bj < 2; ++bj) { const size_t off = (size_t)row * 2048 + col0 + bj * HALF;
                    f32x4 h0, h1;
#pragma unroll
                    for (int k = 0; k < 2; ++k) { h0[2 * k] = __uint_as_float(hv[m][bj][k] << 16); h0[2 * k + 1] = __uint_as_float(hv[m][bj][k] & 0xffff0000u);
                        h1[2 * k] = __uint_as_float(hv[m][bj][2 + k] << 16); h1[2 * k + 1] = __uint_as_float(hv[m][bj][2 + k] & 0xffff0000u); }
                    float ef[8];
#pragma unroll
                    for (int k = 0; k < 4; ++k) { ef[2 * k] = __uint_as_float(ev[m][bj][k] << 16); ef[2 * k + 1] = __uint_as_float(ev[m][bj][k] & 0xffff0000u); }
#pragma unroll
                    for (int k = 0; k < 4; ++k) {
                        h0[k] += ef[k] * __builtin_amdgcn_rcpf(1.0f + __builtin_amdgcn_exp2f(acc[ai][bj][m][0][k] * nr));
                        h1[k] += ef[4 + k] * __builtin_amdgcn_rcpf(1.0f + __builtin_amdgcn_exp2f(acc[ai][bj][m][1][k] * nr)); }
                    *(f32x4*)(out + off) = h0; *(f32x4*)(out + off + 4) = h1; } }
        }
    }
};

template <class Epi, class Sched, bool ALIGN_EPI = false, bool SP2 = false>
__device__ __forceinline__ void gemm_phase(PG8_LAS unsigned char* lds, const Gemm g, const Sched& S, const Epi& E) {
    int tid_ = threadIdx.x; asm volatile("" : "+v"(tid_));
    const int tid = tid_, wid = __builtin_amdgcn_readfirstlane(tid >> 6), lane = tid & 63, wr = wid >> 2, wc = wid & 3, fr = lane & 15, fq = lane >> 4;
    int K_ = g.K; asm volatile("" : "+s"(K_)); const int K = K_, nt = K / BK;
    unsigned voffA[2], voffB[2];
#pragma unroll
    for (int i = 0; i < 2; ++i) { int R, C; stage_rc(tid * 16 + i * 8192, R, C); const int Rb = Epi::PERM ? ((R & ~31) + perm32(R & 31)) : R;
        voffA[i] = (unsigned)(R * K + C) * 2u; voffB[i] = (unsigned)(Rb * K + C) * 2u; }
    const size_t kstep = (size_t)(BK * 2);
    const size_t hstep = (size_t)HALF * K * 2;
    const size_t tstep = 2 * hstep;
    const unsigned ldsw = (unsigned)wid * 1024u;
    const int aoff = lds_byte(wr * 64 + fr, fq * 8), boff = lds_byte(wc * 32 + fr, fq * 8);
#define PG8_SA(b, h) (((b) * 2 + (h)) * HTB)
#define PG8_SB(b, h) ((4 + (b) * 2 + (h)) * HTB)
#define PG8_STAGE(bufoff, gbase, voff) do { _Pragma("unroll") for (int _i = 0; _i < 2; ++_i) \
        __builtin_amdgcn_global_load_lds((const unsigned*)((const char*)(gbase) + (voff)[_i]), (PG8_LAS unsigned*)(lds + (bufoff) + ldsw + _i * 8192), 16, 0, 0); } while (0)
#define PG8_LDA(dst, b, h) do { _Pragma("unroll") for (int m = 0; m < 4; ++m) _Pragma("unroll") for (int k = 0; k < 2; ++k) dst[m][k] = *(const PG8_LAS bf16x8*)(lds + PG8_SA(b, h) + aoff + m * 2048 + k * 1024); } while (0)
#define PG8_LDB(dst, b, h) do { _Pragma("unroll") for (int n = 0; n < 2; ++n) _Pragma("unroll") for (int k = 0; k < 2; ++k) dst[n][k] = *(const PG8_LAS bf16x8*)(lds + PG8_SB(b, h) + boff + n * 2048 + k * 1024); } while (0)
#define PG8_MMA(ai, bj, At, Bt) do { __builtin_amdgcn_s_setprio(1); _Pragma("unroll") for (int m = 0; m < 4; ++m) _Pragma("unroll") for (int n = 0; n < 2; ++n) _Pragma("unroll") for (int k = 0; k < 2; ++k) \
        acc[ai][bj][m][n] = __builtin_amdgcn_mfma_f32_16x16x32_bf16(Bt[n][k], At[m][k], acc[ai][bj][m][n], 0, 0, 0); __builtin_amdgcn_s_setprio(0); } while (0)
#define PG8_WAIT_V(n) asm volatile("s_waitcnt vmcnt(" #n ")" ::: "memory")
#define PG8_WAIT_L(n) asm volatile("s_waitcnt lgkmcnt(" #n ")" ::: "memory")
#define PG8_BAR __builtin_amdgcn_s_barrier()
#define PG8_SCHED __builtin_amdgcn_sched_barrier(0)
    Unit cur, nxt; int ui = 0;
    if (!S.next(0, cur)) return;
    f32x4 acc[2][2][4][2];
#pragma unroll
    for (int a = 0; a < 2; ++a)
#pragma unroll
        for (int b = 0; b < 2; ++b)
#pragma unroll
            for (int m = 0; m < 4; ++m)
#pragma unroll
                for (int n = 0; n < 2; ++n) acc[a][b][m][n] = (f32x4){0.f, 0.f, 0.f, 0.f};
    bf16x8 At[4][2], B0[2][2], B1[2][2];
    const char* cA = (const char*)g.A + (size_t)cur.pm * tstep; const char* cB = (const char*)g.Bt + (size_t)cur.pn * tstep;
    S.a_ready(cur);
    if constexpr (SP2) {
        PG8_STAGE(PG8_SB(0, 0), cB, voffB); PG8_STAGE(PG8_SB(0, 1), cB + hstep, voffB); PG8_STAGE(PG8_SA(0, 0), cA, voffA); PG8_STAGE(PG8_SA(0, 1), cA + hstep, voffA);
        if (wr == 1) PG8_BAR;
        PG8_WAIT_V(2); PG8_BAR;
        PG8_STAGE(PG8_SB(1, 0), cB + kstep, voffB); PG8_STAGE(PG8_SA(1, 0), cA + kstep, voffA); PG8_STAGE(PG8_SB(1, 1), cB + hstep + kstep, voffB);
        PG8_WAIT_V(6); PG8_BAR;
    } else {
        PG8_STAGE(PG8_SB(0, 0), cB, voffB); PG8_STAGE(PG8_SA(0, 0), cA, voffA); PG8_STAGE(PG8_SB(0, 1), cB + hstep, voffB); PG8_STAGE(PG8_SA(0, 1), cA + hstep, voffA);
        if (wr == 1) PG8_BAR;
        PG8_WAIT_V(4); PG8_BAR;
        PG8_STAGE(PG8_SB(1, 0), cB + kstep, voffB); PG8_STAGE(PG8_SA(1, 0), cA + kstep, voffA); PG8_STAGE(PG8_SB(1, 1), cB + hstep + kstep, voffB);
        PG8_WAIT_V(6); PG8_BAR;
    }
    for (;;) {
        const bool has_next = S.next(ui + 1, nxt);
        const char* nA = has_next ? (const char*)g.A + (size_t)nxt.pm * tstep : cA; const char* nB = has_next ? (const char*)g.Bt + (size_t)nxt.pn * tstep : cB;
        for (int t = 0; t < nt; t += 2) {
            const bool last = (t == nt - 2);
            const char* a1 = cA + (size_t)(t + 1) * kstep;
            const char* a2 = last ? nA : cA + (size_t)(t + 2) * kstep; const char* b2 = last ? nB : cB + (size_t)(t + 2) * kstep;
            const char* a3 = a2 + kstep; const char* b3 = b2 + kstep;
            if (last && has_next) S.a_ready(nxt);
            if constexpr (SP2) {
            PG8_LDB(B0, 0, 0); PG8_LDB(B1, 0, 1); PG8_SCHED; PG8_LDA(At, 0, 0); PG8_STAGE(PG8_SA(1, 1), a1 + hstep, voffA);
            PG8_WAIT_V(8); PG8_WAIT_L(0); PG8_BAR; PG8_MMA(0, 0, At, B0); PG8_MMA(0, 1, At, B1); PG8_BAR; PG8_SCHED;
            PG8_LDA(At, 0, 1); PG8_STAGE(PG8_SB(0, 0), b2, voffB); PG8_STAGE(PG8_SB(0, 1), b2 + hstep, voffB); PG8_STAGE(PG8_SA(0, 0), a2, voffA);
            PG8_WAIT_V(8); PG8_WAIT_L(0); PG8_BAR; PG8_MMA(1, 0, At, B0); PG8_MMA(1, 1, At, B1); PG8_BAR; PG8_SCHED;
            PG8_LDB(B0, 1, 0); PG8_LDB(B1, 1, 1); PG8_SCHED; PG8_LDA(At, 1, 0); PG8_STAGE(PG8_SA(0, 1), a2 + hstep, voffA);
            PG8_WAIT_V(8); PG8_WAIT_L(0); PG8_BAR; PG8_MMA(0, 0, At, B0); PG8_MMA(0, 1, At, B1); PG8_BAR; PG8_SCHED;
            PG8_LDA(At, 1, 1); PG8_STAGE(PG8_SB(1, 0), b3, voffB); PG8_STAGE(PG8_SB(1, 1), b3 + hstep, voffB); PG8_STAGE(PG8_SA(1, 0), a3, voffA);
            PG8_WAIT_V(8); PG8_WAIT_L(0); PG8_BAR; PG8_MMA(1, 0, At, B0); PG8_MMA(1, 1, At, B1); PG8_BAR; PG8_SCHED;
            } else {
            PG8_LDB(B0, 0, 0); PG8_SCHED; PG8_LDA(At, 0, 0); PG8_STAGE(PG8_SA(1, 1), a1 + hstep, voffA);
            PG8_WAIT_L(8); PG8_BAR; PG8_WAIT_L(0); PG8_MMA(0, 0, At, B0); PG8_BAR; PG8_SCHED;
            PG8_LDB(B1, 0, 1); PG8_STAGE(PG8_SB(0, 0), b2, voffB);
            PG8_BAR; PG8_WAIT_L(0); PG8_MMA(0, 1, At, B1); PG8_BAR;
            PG8_LDA(At, 0, 1); PG8_STAGE(PG8_SA(0, 0), a2, voffA);
            PG8_BAR; PG8_WAIT_L(0); PG8_MMA(1, 0, At, B0); PG8_BAR; PG8_SCHED;
            PG8_STAGE(PG8_SB(0, 1), b2 + hstep, voffB);
            PG8_WAIT_V(6); PG8_BAR; PG8_MMA(1, 1, At, B1); PG8_BAR;
            PG8_LDB(B0, 1, 0); PG8_SCHED; PG8_LDA(At, 1, 0); PG8_STAGE(PG8_SA(0, 1), a2 + hstep, voffA);
            PG8_WAIT_L(8); PG8_BAR; PG8_WAIT_L(0); PG8_MMA(0, 0, At, B0); PG8_BAR; PG8_SCHED;
            PG8_LDB(B1, 1, 1); PG8_STAGE(PG8_SB(1, 0), b3, voffB);
            PG8_BAR; PG8_WAIT_L(0); PG8_MMA(0, 1, At, B1); PG8_BAR;
            PG8_LDA(At, 1, 1); PG8_STAGE(PG8_SA(1, 0), a3, voffA);
            PG8_BAR; PG8_WAIT_L(0); PG8_MMA(1, 0, At, B0); PG8_BAR; PG8_SCHED;
            PG8_STAGE(PG8_SB(1, 1), b3 + hstep, voffB);
            PG8_WAIT_V(6); PG8_BAR; PG8_MMA(1, 1, At, B1); PG8_BAR;
            }
        }
        if constexpr (ALIGN_EPI) { if (wr == 0) PG8_BAR; }
        if constexpr (!Epi::AFTER_DRAIN) { E(acc, cur, wr, wc, fr, fq); S.done(cur); }
        if (!has_next) break;
#pragma unroll
        for (int a = 0; a < 2; ++a)
#pragma unroll
            for (int b = 0; b < 2; ++b)
#pragma unroll
                for (int m = 0; m < 4; ++m)
#pragma unroll
                    for (int n = 0; n < 2; ++n) acc[a][b][m][n] = (f32x4){0.f, 0.f, 0.f, 0.f};
        cur = nxt; cA = nA; cB = nB; ++ui;
        if constexpr (ALIGN_EPI) { if (wr == 1) PG8_BAR; }
    }
    PG8_WAIT_V(0);
    if constexpr (!ALIGN_EPI) { if (wr == 0) PG8_BAR; }
    PG8_BAR;
    if constexpr (Epi::AFTER_DRAIN) { E.fused(acc, cur, wr, wc, fr, fq, lds, wid, lane); S.done(cur); }
#undef PG8_SA
#undef PG8_SB
#undef PG8_STAGE
#undef PG8_LDA
#undef PG8_LDB
#undef PG8_MMA
#undef PG8_WAIT_V
#undef PG8_WAIT_L
#undef PG8_BAR
#undef PG8_SCHED
}
}
#define LAS __attribute__((address_space(3)))
typedef unsigned short bf16_t;
typedef short bf16x8 __attribute__((ext_vector_type(8)));
typedef short s16x4 __attribute__((ext_vector_type(4)));
typedef float f32x4 __attribute__((ext_vector_type(4)));
typedef float f32x16 __attribute__((ext_vector_type(16)));
typedef unsigned u32x4 __attribute__((ext_vector_type(4)));
typedef unsigned u32x2 __attribute__((ext_vector_type(2)));
using pg8::cvt_pk_bf16;

constexpr int B_ = 4, S_ = 8192, DM = 2048, M_ = B_ * S_, NP = 8192, INW = 8200, PLE = 256, NT = 512;
constexpr int LDS_BYTES = 144 * 1024;
constexpr size_t WS_CTL = 0, WS_TAB = 4096, WS_SUMSQ = 16384, WS_LOGF = WS_SUMSQ + 131072, WS_C = WS_LOGF + (1u << 20), WS_WIN = WS_C + (1u << 20);
constexpr size_t WS_WOUT = WS_WIN + (size_t)NP * DM * 2, WS_WG = WS_WOUT + (size_t)DM * DM * 2, WS_WP = WS_WG + (size_t)DM * DM * 2, WS_PB = WS_WP + (size_t)DM * PLE * 2;
constexpr size_t WS_U = WS_PB + (size_t)M_ * PLE * 2, WS_E = WS_U + (size_t)M_ * DM * 2, WS_QKVZ = WS_E + (size_t)M_ * DM * 2, WS_END = WS_QKVZ + (size_t)M_ * NP * 2;
constexpr size_t WS_BAR = WS_END, WS_TOTAL = WS_END + 16384;
constexpr size_t WS_MIX = WS_U;
constexpr size_t WS_A2 = WS_QKVZ;
constexpr int TAB_LAM = 1056, TAB_AQ2 = 1057, TAB_DBOUND = 1058, TAB_GAIN = 1088;
constexpr int QN = 384;

struct Params { const float* in[19]; float* out; unsigned char* ws; };
enum { I_X = 0, I_P, I_ATTN_NORM, I_W_IN, I_B_FORGET, I_FQN, I_FKN, I_DQN, I_DKN, I_LQ1, I_LK1, I_LQ2, I_LK2, I_DON, I_W_OUT, I_REL_BIAS, I_PLE_PROJ, I_PGN, I_PLE_GATE };

__device__ __forceinline__ float wave_sum(float v) {
#pragma unroll
    for (int o = 32; o >= 1; o >>= 1) v += __shfl_xor(v, o);
    return v;
}
__device__ __forceinline__ float wave_max(float v) {
#pragma unroll
    for (int o = 32; o >= 1; o >>= 1) v = fmaxf(v, __shfl_xor(v, o));
    return v;
}
__device__ __forceinline__ float silu_f(float z) { return z * __builtin_amdgcn_rcpf(1.0f + __builtin_amdgcn_exp2f(-LOG2E * z)); }
__device__ __forceinline__ float bf_lo(unsigned v) { return __uint_as_float(v << 16); }
__device__ __forceinline__ float bf_hi(unsigned v) { return __uint_as_float(v & 0xffff0000u); }

__device__ __forceinline__ void transpose_tile_wave(const float* W, int ldw, int K, bf16_t* Wt, int kt, int ntile, LAS float* tile, int lane, const float* kscale = nullptr) {
    const int k0 = kt * 64, n0 = ntile * 64, kr = lane >> 4, n4 = (lane & 15) * 4;
#pragma unroll
    for (int h = 0; h < 2; ++h) { f32x4 v[8];
#pragma unroll
        for (int i = 0; i < 8; ++i) v[i] = *(const f32x4*)(W + (size_t)(k0 + (h * 8 + i) * 4 + kr) * ldw + n0 + n4);
#pragma unroll
        for (int i = 0; i < 8; ++i) *(LAS f32x4*)(tile + ((h * 8 + i) * 4 + kr) * 68 + n4) = v[i]; }
    asm volatile("s_waitcnt lgkmcnt(0)" ::: "memory");
#pragma unroll
    for (int kc = 0; kc < 8; ++kc) { float v[8];
#pragma unroll
        for (int j = 0; j < 8; ++j) v[j] = tile[(kc * 8 + j) * 68 + lane];
        if (kscale) {
#pragma unroll
            for (int j = 0; j < 8; ++j) v[j] *= kscale[k0 + kc * 8 + j]; }
        u32x4 w; w.x = cvt_pk_bf16(v[0], v[1]); w.y = cvt_pk_bf16(v[2], v[3]); w.z = cvt_pk_bf16(v[4], v[5]); w.w = cvt_pk_bf16(v[6], v[7]);
        *(u32x4*)(Wt + (size_t)(n0 + lane) * K + k0 + kc * 8) = w; }
    asm volatile("s_waitcnt lgkmcnt(0)" ::: "memory");
}

__device__ __forceinline__ void p0_prologue(const Params& P, LAS unsigned char* lds) {
    int tid_ = threadIdx.x; asm volatile("" : "+v"(tid_)); const int tid = tid_, lane = tid & 63, wid = tid >> 6, G = gridDim.x, bx = blockIdx.x;
    unsigned char* ws = P.ws;
    float* tab = (float*)(ws + WS_TAB);
    if (bx == 0) {
        if (tid < 64) ((unsigned*)(ws + WS_CTL))[tid] = 0u;
        for (int i = tid; i < 3456  ; i += NT) ((unsigned*)(ws + WS_BAR))[i] = 0u;
        for (int idx = tid; idx < 8 * 129; idx += NT) { const int h = idx / 129, d = idx % 129; int bk;
            if (d < 16) bk = d; else bk = 15 + (d >= 16) + (d >= 19) + (d >= 21) + (d >= 24) + (d >= 27) + (d >= 31) + (d >= 35) + (d >= 40) + (d >= 46) + (d >= 52) + (d >= 59) + (d >= 67) + (d >= 77) + (d >= 87) + (d >= 99) + (d >= 113);
            tab[h * 132 + d] = P.in[I_REL_BIAS][bk * 8 + h] * LOG2E; }
        { const int c = tid & 127, t = tid >> 7;
          const float gv = (t == 0) ? P.in[I_FQN][c] * (0.08838834764831845f * LOG2E) : (t == 1) ? P.in[I_FKN][c] : (t == 2) ? P.in[I_DQN][c & 63] * (0.125f * LOG2E) : P.in[I_DKN][c & 63];
          tab[TAB_GAIN + tid] = gv; }
        if (wid == 0) { const float s1 = wave_sum(P.in[I_LQ1][lane] * P.in[I_LK1][lane]), s2 = wave_sum(P.in[I_LQ2][lane] * P.in[I_LK2][lane]);
            if (lane == 0) tab[TAB_LAM] = expf(s1) - expf(s2) + 0.2f; }
        if (wid == 1) { const float gq = wave_max(fmaxf(fabsf(P.in[I_FQN][lane]), fabsf(P.in[I_FQN][lane + 64]))), gk = wave_max(fmaxf(fabsf(P.in[I_FKN][lane]), fabsf(P.in[I_FKN][lane + 64])));
            if (lane == 0) tab[TAB_AQ2] = 2.0f * 128.0f * (0.08838834764831845f * LOG2E) * gq * gk * 1.03f; }
        if (wid == 2) {
            const float gq = wave_max(fabsf(P.in[I_DQN][lane])), gk = wave_max(fabsf(P.in[I_DKN][lane]));
            float bm = 0.f;
            for (int i = lane; i < 256; i += 64) bm = fmaxf(bm, fabsf(P.in[I_REL_BIAS][i]));
            bm = wave_max(bm);
            if (lane == 0) tab[TAB_DBOUND] = 64.0f * (0.125f * LOG2E) * gq * gk * 1.03f + 2.0f * LOG2E * bm; }
    }
    { float* sumsq = (float*)(ws + WS_SUMSQ); for (int i = bx * NT + tid; i < M_; i += G * NT) sumsq[i] = 0.f; }
    { const float* p = P.in[I_P]; bf16_t* pb = (bf16_t*)(ws + WS_PB);
      for (int it = bx * NT + tid; it < M_ * PLE / 8; it += 4 * G * NT) { f32x4 a[4], b[4];
#pragma unroll
          for (int k = 0; k < 4; ++k) { const int itk = it + k * G * NT; if (itk < M_ * PLE / 8) { a[k] = *(const f32x4*)(p + (size_t)itk * 8); b[k] = *(const f32x4*)(p + (size_t)itk * 8 + 4); } }
          asm volatile("" ::: "memory");
#pragma unroll
          for (int k = 0; k < 4; ++k) { const int itk = it + k * G * NT; if (itk < M_ * PLE / 8) *(u32x4*)(pb + (size_t)itk * 8) = pg8::pack8(a[k], b[k]); } } }
    { LAS float* mytile = (LAS float*)(lds + wid * (64 * 68 * 4));
      for (int t = bx * 8 + wid; t < 6272; t += G * 8) {
        if (t < 4096) transpose_tile_wave(P.in[I_W_IN], INW, DM, (bf16_t*)(ws + WS_WIN), t & 31, t >> 5, mytile, lane);
        else if (t < 5120) transpose_tile_wave(P.in[I_W_OUT], DM, DM, (bf16_t*)(ws + WS_WOUT), (t - 4096) & 31, (t - 4096) >> 5, mytile, lane);
        else if (t < 6144) transpose_tile_wave(P.in[I_PLE_GATE], DM, DM, (bf16_t*)(ws + WS_WG), (t - 5120) & 31, (t - 5120) >> 5, mytile, lane, P.in[I_PGN]);
        else transpose_tile_wave(P.in[I_PLE_PROJ], DM, PLE, (bf16_t*)(ws + WS_WP), (t - 6144) & 3, (t - 6144) >> 2, mytile, lane);
      } }
    __syncthreads();
    LAS float* wf = (LAS float*)lds;
    for (int i = tid; i < 8 * DM; i += NT) { const int j = i & 7, d = i >> 3; wf[j * DM + d] = P.in[I_W_IN][(size_t)d * INW + NP + j]; }
    __syncthreads();
    const float* x = P.in[I_X]; const float* gain = P.in[I_ATTN_NORM]; bf16_t* U = (bf16_t*)(ws + WS_U); float* logf_ = (float*)(ws + WS_LOGF);
    const float bfg = P.in[I_B_FORGET][lane & 7];
    f32x4 gvec[8];
#pragma unroll
    for (int i = 0; i < 8; ++i) gvec[i] = *(const f32x4*)(gain + 256 * i + 4 * lane);
    f32x4 nx[8], nx2[8];
    { const float* xr0 = x + (size_t)(bx * 8 + wid) * DM; const float* xr1 = x + (size_t)((bx + G) * 8 + wid) * DM;
#pragma unroll
      for (int i = 0; i < 8; ++i) nx[i] = *(const f32x4*)(xr0 + 256 * i + 4 * lane);
      if (bx + G < M_ / 8) {
#pragma unroll
        for (int i = 0; i < 8; ++i) nx2[i] = *(const f32x4*)(xr1 + 256 * i + 4 * lane); } }
    for (int rg = bx; rg < M_ / 8; rg += G) {
        const int row = rg * 8 + wid;
        f32x4 y[8]; float ss = 0.f;
#pragma unroll
        for (int i = 0; i < 8; ++i) { y[i] = nx[i]; ss += pg8::dot4(y[i]); nx[i] = nx2[i]; }
        if (rg + 2 * G < M_ / 8) { const float* xn = x + (size_t)((rg + 2 * G) * 8 + wid) * DM;
#pragma unroll
            for (int i = 0; i < 8; ++i) nx2[i] = *(const f32x4*)(xn + 256 * i + 4 * lane); }
        ss = wave_sum(ss);
        const float rstd = 1.0f / sqrtf(ss * (1.0f / 2048.0f) + 1e-6f);
#pragma unroll
        for (int i = 0; i < 8; ++i) { y[i] = y[i] * rstd * gvec[i];
            u32x2 w; w.x = cvt_pk_bf16(y[i][0], y[i][1]); w.y = cvt_pk_bf16(y[i][2], y[i][3]); *(u32x2*)(U + (size_t)row * DM + 256 * i + 4 * lane) = w; }
        float fmine = 0.f;
#pragma unroll 1
        for (int j = 0; j < 8; ++j) { float fa = 0.f;
#pragma unroll
            for (int i = 0; i < 8; ++i) { const f32x4 wv = *(const LAS f32x4*)(wf + j * DM + 256 * i + 4 * lane); fa += (y[i][0] * wv[0] + y[i][1] * wv[1]) + (y[i][2] * wv[2] + y[i][3] * wv[3]); }
            fa = wave_sum(fa);
            fmine = (lane == j) ? fa : fmine; }
        if (lane < 8) { float z = fmine + bfg;
            const float lf = fminf(z, 0.f) - log1pf(expf(-fabsf(z)));
            const int b = row / S_, s = row % S_;
            logf_[(size_t)(b * 8 + lane) * S_ + s] = lf; }
    }
    __syncthreads();
}

__device__ __forceinline__ void cumsum_seq(const Params& P, LAS unsigned char* lds, int seq) {
    int tid_ = threadIdx.x; asm volatile("" : "+v"(tid_)); const int tid = tid_, lane = tid & 63, wid = tid >> 6;
    const float* src = (const float*)(P.ws + WS_LOGF) + (size_t)seq * S_ + tid * 16; float* dst = (float*)(P.ws + WS_C) + (size_t)seq * S_ + tid * 16;
    float v[16];
#pragma unroll
    for (int i = 0; i < 4; ++i) { const f32x4 t = *(const f32x4*)(src + 4 * i); v[4 * i] = t[0]; v[4 * i + 1] = t[1]; v[4 * i + 2] = t[2]; v[4 * i + 3] = t[3]; }
#pragma unroll
    for (int i = 1; i < 16; ++i) v[i] += v[i - 1];
    float tot = v[15], inc = tot;
#pragma unroll
    for (int o = 1; o < 64; o <<= 1) { const float t = __shfl_up(inc, o); if (lane >= o) inc += t; }
    LAS float* wt = (LAS float*)lds;
    if (lane == 63) wt[wid] = inc;
    __syncthreads();
    float pre = inc - tot;
    for (int k = 0; k < wid; ++k) pre += wt[k];
#pragma unroll
    for (int i = 0; i < 4; ++i) { f32x4 t; t[0] = (v[4 * i] + pre) * LOG2E; t[1] = (v[4 * i + 1] + pre) * LOG2E; t[2] = (v[4 * i + 2] + pre) * LOG2E; t[3] = (v[4 * i + 3] + pre) * LOG2E; *(f32x4*)(dst + 4 * i) = t; }
    __syncthreads();
}
#define XB_TMO      128
#define XB_XCNT(j)  (256  + 64 * (j))
#define XB_XSUB(j)  (1280 + 64 * (j))
#define XB_XGEN(j)  (2304 + 64 * (j))
#define XB_TOP      3328
#define XB_TOPGEN   3392
#define XCD_BAR_WORDS 3456
#define XB_SPIN_CAP (1u << 22)

__device__ __forceinline__ unsigned xb_ld(unsigned* p)              { return __hip_atomic_load(p, __ATOMIC_RELAXED, __HIP_MEMORY_SCOPE_AGENT); }
__device__ __forceinline__ unsigned xb_add(unsigned* p, unsigned v) { return __hip_atomic_fetch_add(p, v, __ATOMIC_RELAXED, __HIP_MEMORY_SCOPE_AGENT); }
__device__ __forceinline__ unsigned xb_xcc_id() { return (unsigned)__builtin_amdgcn_s_getreg((3 << 11) | 20) & 0xFu; }
#define XB_SPIN(cond, bar) do { unsigned _sp = 0; while (cond) { __builtin_amdgcn_s_sleep(1); \
    if ((++_sp & 255u) == 0u) { if (xb_ld(&(bar)[XB_TMO])) break; if (_sp > XB_SPIN_CAP) { atomicAdd(&(bar)[XB_TMO], 1u); break; } } } } while (0)

struct XcdBarrier {
    unsigned* bar; unsigned x;
    volatile LAS unsigned* st;
};

__device__ __forceinline__ XcdBarrier xcd_barrier_post(unsigned* bar, volatile LAS unsigned* st) {
    XcdBarrier b; b.bar = bar; b.x = xb_xcc_id(); b.st = st;
    if (threadIdx.x == 0) (void)xb_add(&bar[XB_XCNT(b.x)], 1u);
    return b;
}
__device__ __forceinline__ void xcd_barrier_complete(unsigned* bar, unsigned x, unsigned& nloc, unsigned& nx) {
    const unsigned G = gridDim.x * gridDim.y * gridDim.z;
    unsigned sum, cnt, mine, sp = 0u;
    for (;;) {
        sum = 0u; cnt = 0u; mine = 0u;
#pragma unroll
        for (unsigned j = 0; j < 16; ++j) { const unsigned c = xb_ld(&bar[XB_XCNT(j)]); sum += c; cnt += (c > 0u) ? 1u : 0u; mine = (j == x) ? c : mine; }
        if (sum == G) break;
        __builtin_amdgcn_s_sleep(1);
        if ((++sp & 255u) == 0u) { if (xb_ld(&bar[XB_TMO])) break; if (sp > XB_SPIN_CAP) { atomicAdd(&bar[XB_TMO], 1u); break; } }
    }
    nloc = mine > 0u ? mine : 1u; nx = cnt > 0u ? cnt : 1u;
}

__device__ __forceinline__ void xcd_barrier(const XcdBarrier& b) {
    asm volatile("s_waitcnt vmcnt(0)" ::: "memory");
    __syncthreads();
    if (threadIdx.x == 0) {
        unsigned* bar = b.bar;
        __builtin_amdgcn_s_waitcnt(0);
        unsigned nloc = b.st[0], nx = b.st[1];
        if (nloc == 0u) { xcd_barrier_complete(bar, b.x, nloc, nx); b.st[0] = nloc; b.st[1] = nx; }
        const unsigned old = xb_add(&bar[XB_XSUB(b.x)], 1u);
        const unsigned gen = old / nloc;
        if (old + 1u == (gen + 1u) * nloc) {
            __builtin_amdgcn_fence(__ATOMIC_RELEASE, "agent");
            asm volatile("s_waitcnt vmcnt(0)" ::: "memory");
            const unsigned og = xb_add(&bar[XB_TOP], 1u);
            const unsigned tg = og / nx;
            if (og + 1u == (tg + 1u) * nx) xb_add(&bar[XB_TOPGEN], 1u);
            else XB_SPIN(xb_ld(&bar[XB_TOPGEN]) == tg, bar);
            __builtin_amdgcn_fence(__ATOMIC_ACQUIRE, "agent");
            xb_add(&bar[XB_XGEN(b.x)], 1u);
            asm volatile("s_waitcnt vmcnt(0)" ::: "memory");
        } else {
            XB_SPIN(xb_ld(&bar[XB_XGEN(b.x)]) == gen, bar);
            __builtin_amdgcn_fence(__ATOMIC_ACQUIRE, "agent");
            asm volatile("s_waitcnt vmcnt(0)" ::: "memory");
        }
    }
    __syncthreads();
}


#define MFMA32(a, b, c) __builtin_amdgcn_mfma_f32_32x32x16_bf16((a), (b), (c), 0, 0, 0)
constexpr int AL_NBUF = 4, AL_PD = 3, AL_CLS = 131072, AL_MISC = AL_CLS + 8192, AL_BIAS = AL_MISC + 256;
#define ATT_WAITV(n) asm volatile("s_waitcnt vmcnt(" #n ")" ::: "memory")

template <bool ONLINE, int NO>
__device__ __forceinline__ void softmax_tile(f32x16 (&s)[2], float& m, float& l, f32x16 (&O)[NO], u32x4 (&pk)[4]) {
    float mn = 0.f;
    if (ONLINE) {
        float mx = s[0][0];
#pragma unroll
        for (int i = 1; i < 16; ++i) mx = fmaxf(mx, s[0][i]);
#pragma unroll
        for (int i = 0; i < 16; ++i) mx = fmaxf(mx, s[1][i]);
        mx = fmaxf(mx, __shfl_xor(mx, 32));
        mn = fmaxf(m, mx);
        if (__builtin_amdgcn_ballot_w64(mn > m) != 0ull) {
            const float alpha = __builtin_amdgcn_exp2f(m - mn);
            m = mn; l *= alpha;
#pragma unroll
            for (int d = 0; d < NO; ++d) O[d] = O[d] * alpha;
        }
    }
    float ps = 0.f;
#pragma unroll
    for (int blk = 0; blk < 2; ++blk)
#pragma unroll
        for (int i = 0; i < 16; ++i) { const float p = __builtin_amdgcn_exp2f(ONLINE ? (s[blk][i] - mn) : s[blk][i]); ps += p; s[blk][i] = p; }
    l += ps;
#pragma unroll
    for (int blk = 0; blk < 2; ++blk)
#pragma unroll
        for (int sh = 0; sh < 2; ++sh) { u32x4 pw;
            pw.x = cvt_pk_bf16(s[blk][8 * sh], s[blk][8 * sh + 1]); pw.y = cvt_pk_bf16(s[blk][8 * sh + 2], s[blk][8 * sh + 3]);
            pw.z = cvt_pk_bf16(s[blk][8 * sh + 4], s[blk][8 * sh + 5]); pw.w = cvt_pk_bf16(s[blk][8 * sh + 6], s[blk][8 * sh + 7]); pk[2 * blk + sh] = pw; }
}


template <int G>
__device__ __forceinline__ void v_issue(s16x4 (&v)[8], const unsigned addr) {
    asm volatile("ds_read_b64_tr_b16 %0, %8 offset:%9\n\tds_read_b64_tr_b16 %1, %8 offset:%10\n\tds_read_b64_tr_b16 %2, %8 offset:%11\n\tds_read_b64_tr_b16 %3, %8 offset:%12\n\t"
                 "ds_read_b64_tr_b16 %4, %8 offset:%13\n\tds_read_b64_tr_b16 %5, %8 offset:%14\n\tds_read_b64_tr_b16 %6, %8 offset:%15\n\tds_read_b64_tr_b16 %7, %8 offset:%16"
                 : "=&v"(v[0]), "=&v"(v[1]), "=&v"(v[2]), "=&v"(v[3]), "=&v"(v[4]), "=&v"(v[5]), "=&v"(v[6]), "=&v"(v[7])
                 : "v"(addr), "i"(G * 4096), "i"(G * 4096 + 256), "i"(G * 4096 + 512), "i"(G * 4096 + 768), "i"(G * 4096 + 1024), "i"(G * 4096 + 1280), "i"(G * 4096 + 1536), "i"(G * 4096 + 1792));
}
template <int N>
__device__ __forceinline__ void v_wait(s16x4 (&v)[8]) {
    asm volatile("s_waitcnt lgkmcnt(%8)" : "+v"(v[0]), "+v"(v[1]), "+v"(v[2]), "+v"(v[3]), "+v"(v[4]), "+v"(v[5]), "+v"(v[6]), "+v"(v[7]) : "i"(N));
}
__device__ __forceinline__ void k_issue4(bf16x8 (&k)[8], const unsigned a0, const unsigned a1, const unsigned a2, const unsigned a3) {
    asm volatile("ds_read_b128 %0, %8\n\tds_read_b128 %1, %8 offset:8192\n\tds_read_b128 %2, %9\n\tds_read_b128 %3, %9 offset:8192\n\t"
                 "ds_read_b128 %4, %10\n\tds_read_b128 %5, %10 offset:8192\n\tds_read_b128 %6, %11\n\tds_read_b128 %7, %11 offset:8192"
                 : "=&v"(k[0]), "=&v"(k[1]), "=&v"(k[2]), "=&v"(k[3]), "=&v"(k[4]), "=&v"(k[5]), "=&v"(k[6]), "=&v"(k[7])
                 : "v"(a0), "v"(a1), "v"(a2), "v"(a3));
}
template <int N>
__device__ __forceinline__ void k_wait(bf16x8 (&k)[8]) {
    asm volatile("s_waitcnt lgkmcnt(%8)" : "+v"(k[0]), "+v"(k[1]), "+v"(k[2]), "+v"(k[3]), "+v"(k[4]), "+v"(k[5]), "+v"(k[6]), "+v"(k[7]) : "i"(N));
}
#define ATT_PV(v_, p_) do { const bf16x8 pf_ = __builtin_bit_cast(bf16x8, (p_)); _Pragma("unroll") for (int d = 0; d < 4; ++d) { \
        const bf16x8 vf_ = __builtin_shufflevector((v_)[2 * d], (v_)[2 * d + 1], 0, 1, 2, 3, 4, 5, 6, 7); O[d] = MFMA32(vf_, pf_, O[d]); } } while (0)

template <int MODE>
__device__ __forceinline__ void attn_unit(const Params& P, LAS unsigned char* lds, const int b, const int h, const int qb) {
    constexpr bool FOX = (MODE == 0), ONLINE = (MODE != 1);
    constexpr int ROWS = FOX ? 256 : 128, NQ = FOX ? 8 : 4;
    int tid_ = threadIdx.x; asm volatile("" : "+v"(tid_));
    const int tid = tid_, lane = tid & 63, w = __builtin_amdgcn_readfirstlane(tid >> 6), r = lane & 31, hh = lane >> 5;
    const int mp = FOX ? 0 : (w >> 2);
    const int q0 = qb * ROWS, q0w = q0 + 32 * (FOX ? w : (w & 3)), q = q0w + r;
    bf16_t* QKVZ = (bf16_t*)(P.ws + WS_QKVZ);
    const float* tab = (const float*)(P.ws + WS_TAB);
    const size_t tokbase = (size_t)b * S_;
    const int colO = FOX ? h * 128 : 1024 + h * 128;
    constexpr size_t TS = (size_t)4 * 8 * 8192 * 128;
    const size_t hb = ((size_t)(b * 8 + h)) * 8192 * 128;
    const bf16_t* Qb = QKVZ + (FOX ? 0 : 4) * TS + hb; const bf16_t* Kb_ = QKVZ + (FOX ? 1 : 5) * TS + hb;
    const bf16_t* Vb_ = QKVZ + (FOX ? 2 : 6) * TS + hb; const bf16_t* Zb = QKVZ + (FOX ? 3 : 7) * TS + hb;
    constexpr int RS = 128;
    bf16x8 Qf[NQ];
    { const bf16_t* qp = Qb + (size_t)q * RS + (FOX ? 0 : 64 * mp) + 8 * hh;
#pragma unroll
      for (int ks = 0; ks < NQ; ++ks) Qf[ks] = *(const bf16x8*)(qp + 16 * ks); }
    const int nt = (q0 + ROWS) / 64;
    int kt0 = 0;
    const float* Cl = (const float*)(P.ws + WS_C) + (size_t)(b * 8 + h) * S_;
    if (FOX) {
        const int kd = q0 / 64; int pred = 0;
        if (tid < kd) pred = (tab[TAB_AQ2] + Cl[q0] - Cl[tid * 64 + 63] >= -150.0f) ? 1 : 0;
        kt0 = kd - __syncthreads_count(pred);
    } else {
        if (tid < 129) ((LAS float*)(lds + AL_BIAS))[tid] = tab[h * 132 + tid] - tab[h * 132 + 128];
    }
    const int krow = 4 * w + (lane >> 4), kchunk = (lane & 15) ^ (krow & 15);
    const bf16_t* kg = Kb_ + (size_t)krow * RS + kchunk * 8;
    const int vst = 2 * w + (lane >> 5), vkey = (vst >> 2) * 8 + ((lane >> 2) & 7);
    const bf16_t* vg = Vb_ + (size_t)vkey * RS + (vst & 3) * 32 + (lane & 3) * 8;
    const float* cg_ = Cl + lane;
#define ATT_DMA(kt_, buf_) do { const size_t ro_ = (size_t)((kt_) * 64) * RS; LAS unsigned char* b_ = lds + (buf_) * 32768 + w * 1024; \
        __builtin_amdgcn_global_load_lds((const unsigned*)(kg + ro_), (LAS unsigned*)(b_), 16, 0, 0); \
        __builtin_amdgcn_global_load_lds((const unsigned*)(kg + ro_ + (size_t)32 * RS), (LAS unsigned*)(b_ + 8192), 16, 0, 0); \
        __builtin_amdgcn_global_load_lds((const unsigned*)(vg + ro_), (LAS unsigned*)(b_ + 16384), 16, 0, 0); \
        __builtin_amdgcn_global_load_lds((const unsigned*)(vg + ro_ + (size_t)32 * RS), (LAS unsigned*)(b_ + 16384 + 8192), 16, 0, 0); \
        if (FOX) __builtin_amdgcn_global_load_lds((const unsigned*)(cg_ + (kt_) * 64), (LAS unsigned*)(lds + AL_CLS + ((buf_) * 8 + w) * 256), 4, 0, 0); } while (0)
    const int pr = (r & 19) | ((r & 4) << 1) | ((r & 8) >> 1);
    const unsigned kra = pr * 256, kswz = pr & 15;
    const unsigned vra = 16384 + hh * 2048 + ((lane & 15) >> 2) * 64 + ((lane >> 4) & 1) * 32 + (lane & 3) * 8;
    f32x16 O[4];
#pragma unroll
    for (int d = 0; d < 4; ++d)
#pragma unroll
        for (int i = 0; i < 16; ++i) O[d][i] = 0.f;
    float m1 = ONLINE ? -INFINITY : 0.f, l1 = 0.f;
    const int ktw_last = (q0w + 31) / 64;

    ATT_WAITV(0); __builtin_amdgcn_s_barrier(); asm volatile("" ::: "memory");
#pragma unroll
    for (int i = 0; i < AL_PD; ++i) if (kt0 + i < nt) ATT_DMA(kt0 + i, i);
    for (int kt = kt0; kt < nt; ++kt) {
        const int rel = kt - kt0, cur = rel & (AL_NBUF - 1);
        if (kt + 2 < nt) { if (FOX) ATT_WAITV(10); else ATT_WAITV(8); } else if (kt + 1 < nt) { if (FOX) ATT_WAITV(5); else ATT_WAITV(4); } else ATT_WAITV(0);
        __builtin_amdgcn_s_barrier(); asm volatile("" ::: "memory");
        if (kt + AL_PD < nt) ATT_DMA(kt + AL_PD, (rel + AL_PD) & (AL_NBUF - 1));
        if (kt <= ktw_last) {
            const LAS unsigned char* Kb = lds + cur * 32768;
            const int kbase = kt * 64 + 8 * hh;
            u32x4 pk1[4];
            f32x16 s[2];
#pragma unroll
            for (int i = 0; i < 16; ++i) { s[0][i] = 0.f; s[1][i] = 0.f; }
            s16x4 va[8], vb[8], vc[8], vd[8];
            const unsigned vaddr = (unsigned)(uintptr_t)(Kb + vra);
            if constexpr (MODE == 1) {
                bf16x8 kf[8];
                const unsigned kb_ = (unsigned)(uintptr_t)Kb + kra, c0 = mp * 8 + hh;
                k_issue4(kf, kb_ + (((c0) ^ kswz) << 4), kb_ + (((c0 + 2) ^ kswz) << 4), kb_ + (((c0 + 4) ^ kswz) << 4), kb_ + (((c0 + 6) ^ kswz) << 4));
                v_issue<0>(va, vaddr);
                k_wait<8>(kf);
#pragma unroll
                for (int ks = 0; ks < 4; ++ks) { s[0] = MFMA32(kf[2 * ks], Qf[ks], s[0]); s[1] = MFMA32(kf[2 * ks + 1], Qf[ks], s[1]); }
                v_issue<1>(vb, vaddr);
            } else {
#pragma unroll
            for (int ks = 0; ks < NQ; ++ks) {
                const unsigned chunk = mp * 8 + 2 * ks + hh;
                const unsigned off = kra + ((chunk ^ kswz) << 4);
                const bf16x8 a0 = *(const LAS bf16x8*)(Kb + off), a1 = *(const LAS bf16x8*)(Kb + off + 8192);
                s[0] = MFMA32(a0, Qf[ks], s[0]); s[1] = MFMA32(a1, Qf[ks], s[1]);
            }
            v_issue<0>(va, vaddr);
            }
            if (FOX) {
                const LAS float* cl = (const LAS float*)(lds + AL_CLS + (cur * 8 + w) * 256) + 8 * hh;
#pragma unroll
                for (int blk = 0; blk < 2; ++blk)
#pragma unroll
                    for (int j4 = 0; j4 < 4; ++j4) { const f32x4 c = *(const LAS f32x4*)(cl + 32 * blk + 16 * (j4 >> 1) + 4 * (j4 & 1));
#pragma unroll
                        for (int e = 0; e < 4; ++e) s[blk][4 * j4 + e] -= c[e]; }
            } else if (q0w - kt * 64 - 63 < 128) {
                const LAS float* bl = (const LAS float*)(lds + AL_BIAS);
#pragma unroll
                for (int blk = 0; blk < 2; ++blk)
#pragma unroll
                    for (int i = 0; i < 16; ++i) { const int dist = q - (kbase + 32 * blk + 16 * (i >> 3) + (i & 7)); const int di = dist < 0 ? 0 : (dist > 128 ? 128 : dist); s[blk][i] += bl[di]; }
            }
            if (kt * 64 + 63 > q0w) {
#pragma unroll
                for (int blk = 0; blk < 2; ++blk)
#pragma unroll
                    for (int i = 0; i < 16; ++i) { if (kbase + 32 * blk + 16 * (i >> 3) + (i & 7) > q) s[blk][i] = -INFINITY; }
            }
            softmax_tile<ONLINE, 4>(s, m1, l1, O, pk1);
            if constexpr (MODE == 1) {
                v_issue<2>(vc, vaddr); v_wait<15>(va); ATT_PV(va, pk1[0]); v_issue<3>(vd, vaddr); v_wait<15>(vb); ATT_PV(vb, pk1[1]); v_wait<8>(vc); ATT_PV(vc, pk1[2]); v_wait<0>(vd); ATT_PV(vd, pk1[3]);
            } else {
            v_issue<1>(vb, vaddr); v_wait<8>(va); ATT_PV(va, pk1[0]);
            v_issue<2>(va, vaddr); v_wait<8>(vb); ATT_PV(vb, pk1[1]);
            v_issue<3>(vb, vaddr); v_wait<8>(va); ATT_PV(va, pk1[2]);
            v_wait<0>(vb); ATT_PV(vb, pk1[3]);
            }
        }
    }
#undef ATT_DMA
    bf16_t* mix = (bf16_t*)(P.ws + WS_MIX) + (tokbase + q) * DM + colO;
    const bf16_t* zp = Zb + (size_t)q * RS;
    const float inv1 = 1.0f / (l1 + __shfl_xor(l1, 32));
    u32x2 zv[4][4]; f32x4 gv[4][4];
    if (FOX || mp == 0) {
#pragma unroll
        for (int d = 0; d < 4; ++d)
#pragma unroll
            for (int a = 0; a < 4; ++a) { const int d0 = 32 * d + 8 * a + 4 * hh; zv[d][a] = *(const u32x2*)(zp + d0); if (!FOX) gv[d][a] = *(const f32x4*)(P.in[I_DON] + d0); }
    }
    asm volatile("" ::: "memory");
    if (FOX) {
#pragma unroll
        for (int d = 0; d < 4; ++d)
#pragma unroll
            for (int a = 0; a < 4; ++a) { const int d0 = 32 * d + 8 * a + 4 * hh; const u32x2 z2 = zv[d][a];
                const float o0 = O[d][4 * a] * inv1 * silu_f(bf_lo(z2.x)), o1 = O[d][4 * a + 1] * inv1 * silu_f(bf_hi(z2.x));
                const float o2 = O[d][4 * a + 2] * inv1 * silu_f(bf_lo(z2.y)), o3 = O[d][4 * a + 3] * inv1 * silu_f(bf_hi(z2.y));
                u32x2 ov; ov.x = cvt_pk_bf16(o0, o1); ov.y = cvt_pk_bf16(o2, o3); *(u32x2*)(mix + d0) = ov; }
        __syncthreads();
    } else {
        __syncthreads();
        LAS float* xb = (LAS float*)lds;
        if (mp == 1) {
#pragma unroll
            for (int d = 0; d < 4; ++d)
#pragma unroll
                for (int i = 0; i < 16; ++i) xb[(((w & 3) * 4 + d) * 16 + i) * 64 + lane] = O[d][i] * inv1;
        }
        __syncthreads();
        if (mp == 0) {
            const float lam = tab[TAB_LAM]; float ss = 0.f;
#pragma unroll
            for (int d = 0; d < 4; ++d)
#pragma unroll
                for (int i = 0; i < 16; ++i) { const float o = O[d][i] * inv1 - lam * xb[((w * 4 + d) * 16 + i) * 64 + lane]; O[d][i] = o; ss += o * o; }
            ss += __shfl_xor(ss, 32);
            const float rstd = 0.8f * __builtin_amdgcn_rsqf(ss * (1.0f / 128.0f) + 1e-6f);
#pragma unroll
            for (int d = 0; d < 4; ++d)
#pragma unroll
                for (int a = 0; a < 4; ++a) { const int d0 = 32 * d + 8 * a + 4 * hh; const u32x2 z2 = zv[d][a]; const f32x4 g = gv[d][a];
                    const float o0 = O[d][4 * a] * rstd * g[0] * silu_f(bf_lo(z2.x)), o1 = O[d][4 * a + 1] * rstd * g[1] * silu_f(bf_hi(z2.x));
                    const float o2 = O[d][4 * a + 2] * rstd * g[2] * silu_f(bf_lo(z2.y)), o3 = O[d][4 * a + 3] * rstd * g[3] * silu_f(bf_hi(z2.y));
                    u32x2 ov; ov.x = cvt_pk_bf16(o0, o1); ov.y = cvt_pk_bf16(o2, o3); *(u32x2*)(mix + d0) = ov; }
        }
        __syncthreads();
    }
}

__device__ __forceinline__ void attn_phase(const Params& P, LAS unsigned char* lds) {
    int tid_ = threadIdx.x; asm volatile("" : "+v"(tid_)); const int tid = tid_;
    unsigned* ctr = (unsigned*)(P.ws + WS_CTL);
    LAS int* misc = (LAS int*)(lds + AL_MISC);
    const int xq = (int)(__builtin_amdgcn_s_getreg((3 << 11) | 20) & 7u);
    const bool bounded = ((const float*)(P.ws + WS_TAB))[TAB_DBOUND] <= 60.0f;
    for (;;) {
        if (tid == 0) { int u = -1;
            for (int k = 0; k < 8; ++k) { const int qi = (xq + k) & 7; const unsigned v = atomicAdd(ctr + qi, 1u); if (v < (unsigned)QN) { u = qi * QN + (int)v; break; } }
            misc[0] = u; }
        __syncthreads();
        const int u = misc[0];
        __syncthreads();
        if (u < 0) break;
        const int qi = u / QN, v = u % QN;
        if (v < 256) { const int bh = qi * 4 + (v >> 6), qb = 63 - (v & 63); if (bounded) attn_unit<1>(P, lds, bh >> 3, bh & 7, qb); else attn_unit<2>(P, lds, bh >> 3, bh & 7, qb); }
        else { const int v2 = v - 256; const int bh = qi * 4 + (v2 >> 5), qb = 31 - (v2 & 31); attn_unit<0>(P, lds, bh >> 3, bh & 7, qb); }
    }
}

__global__ void __launch_bounds__(NT, 2) hymba_fwd(Params P) {
    extern __shared__ __attribute__((aligned(16))) unsigned char lds_raw[];
    LAS unsigned char* lds = (LAS unsigned char*)lds_raw;
    cg::grid_group grid = cg::this_grid();
    unsigned char* ws = P.ws;
    const int G = gridDim.x, bx = blockIdx.x;

    volatile LAS unsigned* xst = (volatile LAS unsigned*)(lds + LDS_BYTES - 16);
    if (threadIdx.x < 2) xst[threadIdx.x] = 0u;
    __syncthreads();

    p0_prologue(P, lds);
    grid.sync();
    const XcdBarrier xbar = xcd_barrier_post((unsigned*)(ws + WS_BAR), xst);

    {
        pg8::Gemm g{(const bf16_t*)(ws + WS_U), (const bf16_t*)(ws + WS_WIN), M_, NP, DM}; pg8::StaticOrder S; S.init(M_, NP, G, bx);
        pg8::EpiProj E{(bf16_t*)(ws + WS_QKVZ), (const float*)(ws + WS_TAB) + TAB_GAIN, (LAS float*)(lds + pg8::STAGE_BYTES)};
        pg8::gemm_phase<pg8::EpiProj, pg8::StaticOrder, true, true>(lds, g, S, E);
    }
    {
        pg8::Gemm g{(const bf16_t*)(ws + WS_PB), (const bf16_t*)(ws + WS_WP), M_, DM, PLE}; pg8::StaticOrder S; S.init(M_, DM, G, bx);
        pg8::EpiPlain E{(bf16_t*)(ws + WS_E), DM};
        pg8::gemm_phase<pg8::EpiPlain, pg8::StaticOrder, true, true>(lds, g, S, E);
    }
    if (bx < 32) cumsum_seq(P, lds, bx);
    xcd_barrier(xbar);

    attn_phase(P, lds);
    xcd_barrier(xbar);

    {
        pg8::Gemm g{(const bf16_t*)(ws + WS_MIX), (const bf16_t*)(ws + WS_WOUT), M_, DM, DM}; pg8::StaticOrder S; S.init(M_, DM, G, bx);
        pg8::EpiOut E{P.in[I_X], (bf16_t*)(ws + WS_A2), (float*)(ws + WS_SUMSQ)};
        pg8::gemm_phase<pg8::EpiOut, pg8::StaticOrder, true, true>(lds, g, S, E);
    }
    xcd_barrier(xbar);
    {
        pg8::Gemm g{(const bf16_t*)(ws + WS_A2), (const bf16_t*)(ws + WS_WG), M_, DM, DM}; pg8::StaticOrder S; S.init(M_, DM, G, bx);
        pg8::EpiGate E{P.out, (const bf16_t*)(ws + WS_A2), (const bf16_t*)(ws + WS_E), (const float*)(ws + WS_SUMSQ)};
        pg8::gemm_phase<pg8::EpiGate, pg8::StaticOrder, true, true>(lds, g, S, E);
    }
}

extern "C" void kernel_launch(void* const* d_in, const int* in_sizes, int n_in, void* d_out, int out_size, void* d_ws, size_t ws_size, hipStream_t stream) {
    static int grid = 0;
    if (grid == 0) {
        if (n_in != 19 || out_size != M_ * DM || ws_size < WS_TOTAL) { fprintf(stderr, "kernel_launch: unexpected shapes (n_in %d, out %d, ws %zu < %zu)\n", n_in, out_size, ws_size, (size_t)WS_TOTAL); grid = -1; return; }
        int dev = 0, cus = 0, per_cu = 0;
        hipGetDevice(&dev); hipDeviceGetAttribute(&cus, hipDeviceAttributeMultiprocessorCount, dev);
        if (hipFuncSetAttribute((const void*)hymba_fwd, hipFuncAttributeMaxDynamicSharedMemorySize, LDS_BYTES) != hipSuccess) { fprintf(stderr, "kernel_launch: hipFuncSetAttribute failed\n"); grid = -1; return; }
        if (hipOccupancyMaxActiveBlocksPerMultiprocessor(&per_cu, (const void*)hymba_fwd, NT, LDS_BYTES) != hipSuccess || per_cu < 1) { fprintf(stderr, "kernel_launch: occupancy query gives %d\n", per_cu); per_cu = 1; }
        (void)hipGetLastError();
        grid = cus * (per_cu > 1 ? 1 : per_cu);
    }
    if (grid < 0) return;
    Params p{};
    for (int i = 0; i < 19; ++i) p.in[i] = (const float*)d_in[i];
    p.out = (float*)d_out; p.ws = (unsigned char*)d_ws;
    void* args[] = {&p};
    const hipError_t e = hipLaunchCooperativeKernel((const void*)hymba_fwd, dim3(grid), dim3(NT), args, LDS_BYTES, stream);
    if (e != hipSuccess) fprintf(stderr, "kernel_launch: cooperative launch failed: %s (grid %d)\n", hipGetErrorString(e), grid);
}
```

```cpp
#include <hip/hip_runtime.h>
#include <hip/hip_cooperative_groups.h>
#include <cstdio>
#include <cstdint>
namespace cg = cooperative_groups;

constexpr float LOG2E = 1.4426950408889634f;
namespace pg8 {
#define PG8_LAS __attribute__((address_space(3)))
typedef unsigned short bf16_t;
typedef short bf16x8 __attribute__((ext_vector_type(8)));
typedef float f32x4 __attribute__((ext_vector_type(4)));
typedef unsigned u32x4 __attribute__((ext_vector_type(4)));
constexpr int BM = 256, BK = 64, HALF = 128, HTB = HALF * BK * 2  , STAGE_BYTES = 8 * HTB, NXCD = 8, WGM = 2;

__host__ __device__ __forceinline__ int lds_byte(int r, int c) { const int st = (r >> 4) * 2 + (c >> 5), rr = r & 15, cc = c & 31, ob = rr * 64 + cc * 2; return st * 1024 + (ob ^ (((ob >> 9) & 1) << 5)); }
__host__ __device__ __forceinline__ void stage_rc(int b, int& R, int& C) { const int st = b / 1024, sb = b % 1024, swz = sb ^ (((sb >> 9) & 1) << 5); R = (st >> 1) * 16 + swz / 64; C = (st & 1) * 32 + (swz % 64) / 2; }
__host__ __device__ __forceinline__ int perm32(int rho) { const int n = rho >> 4, i = rho & 15; return 8 * (i >> 2) + 4 * n + (i & 3); }

struct Unit { int pm, pn; };
struct Gemm { const bf16_t* A; const bf16_t* Bt; int M, N, K; };

struct StaticOrder {
    int nM, nN, nwg, G, c;
    __host__ __device__ void init(int M, int N, int G_, int c_) { nM = M / BM; nN = N / BM; nwg = nM * nN; G = G_; c = c_; }
    __host__ __device__ bool next(int i, Unit& u) const {
        const long L = (long)i * G + c; if (L >= nwg) return false;
        int wgid = (int)L; { const int q = nwg / NXCD, r = nwg % NXCD, xcd = wgid % NXCD, off = wgid / NXCD; wgid = (xcd < r ? xcd * (q + 1) : r * (q + 1) + (xcd - r) * q) + off; }
        const int nig = WGM * nN, gid = wgid / nig, fm = gid * WGM, gsz = (nM - fm) < WGM ? (nM - fm) : WGM;
        u.pm = fm + ((wgid % nig) % gsz); u.pn = (wgid % nig) / gsz; return true;
    }
    __device__ __forceinline__ void a_ready(const Unit&) const {}
    __device__ __forceinline__ void done(const Unit&) const {}
};

__device__ __forceinline__ unsigned cvt_pk_bf16(float lo, float hi) {
    typedef __bf16 bf2_t __attribute__((ext_vector_type(2))); typedef float f2_t __attribute__((ext_vector_type(2)));
    f2_t v = {lo, hi}; return __builtin_bit_cast(unsigned, __builtin_convertvector(v, bf2_t));
}
__device__ __forceinline__ u32x4 pack8(const f32x4 a, const f32x4 b) { u32x4 w; w.x = cvt_pk_bf16(a[0], a[1]); w.y = cvt_pk_bf16(a[2], a[3]); w.z = cvt_pk_bf16(b[0], b[1]); w.w = cvt_pk_bf16(b[2], b[3]); return w; }
__device__ __forceinline__ float dot4(const f32x4 a) { return (a[0] * a[0] + a[1] * a[1]) + (a[2] * a[2] + a[3] * a[3]); }

struct EpiPlain {
    static constexpr bool PERM = true, AFTER_DRAIN = false;
    bf16_t* O; int ldc;
    __device__ __forceinline__ void operator()(const f32x4 (&acc)[2][2][4][2], const Unit& u, int wr, int wc, int fr, int fq) const {
        const int row0 = u.pm * BM + wr * 64 + fr, col0 = u.pn * BM + wc * 32 + 8 * fq;
#pragma unroll
        for (int ai = 0; ai < 2; ++ai)
#pragma unroll
            for (int m = 0; m < 4; ++m) { bf16_t* rowp = O + (size_t)(row0 + ai * HALF + m * 16) * ldc + col0;
#pragma unroll
                for (int bj = 0; bj < 2; ++bj) *(u32x4*)(rowp + bj * HALF) = pack8(acc[ai][bj][m][0], acc[ai][bj][m][1]); }
    }
};

struct EpiProj {
    static constexpr bool PERM = true, AFTER_DRAIN = false;
    bf16_t* O; const float* gtab; PG8_LAS float* red;
    __device__ __forceinline__ void operator()(const f32x4 (&acc)[2][2][4][2], const Unit& u, int wr, int wc, int fr, int fq) const {
        const int type = u.pn >> 2;
        const int row0 = u.pm * BM + wr * 64 + fr;
        bf16_t* const Ot = O + (((size_t)type * 4 + (size_t)(u.pm >> 5)) * 8 + (size_t)((u.pn & 3) * 2)) * 8192 * 128 + (size_t)(u.pm & 31) * 256 * 128;
        unsigned char* const Ot1 = (unsigned char*)(Ot + (size_t)8192 * 128);
        const unsigned voff = (unsigned)(((wr * 64 + fr) * 128 + wc * 32 + 8 * fq) * 2);
        const bool isnorm = (type == 0) || (type == 1) || (type == 4) || (type == 5);
        if (!isnorm) {
#pragma unroll
            for (int ai = 0; ai < 2; ++ai)
#pragma unroll
                for (int m = 0; m < 4; ++m) { const unsigned vo = voff + (unsigned)((ai * HALF + m * 16) * 256);
                    *(u32x4*)((unsigned char*)Ot + vo) = pack8(acc[ai][0][m][0], acc[ai][0][m][1]); *(u32x4*)(Ot1 + vo) = pack8(acc[ai][1][m][0], acc[ai][1][m][1]); }
        } else {
            const bool isdiff = type >= 4;
#pragma unroll
            for (int ai = 0; ai < 2; ++ai)
#pragma unroll
                for (int m = 0; m < 4; ++m)
#pragma unroll
                    for (int bj = 0; bj < 2; ++bj) {
                        float s = dot4(acc[ai][bj][m][0]) + dot4(acc[ai][bj][m][1]);
                        s += __shfl_xor(s, 16); s += __shfl_xor(s, 32);
                        if (fq == 0) red[(ai * HALF + wr * 64 + m * 16 + fr) * 8 + bj * 4 + wc] = s;
                    }
            asm volatile("s_waitcnt lgkmcnt(0)" ::: "memory"); __builtin_amdgcn_s_barrier(); asm volatile("" ::: "memory");
            const float* gp = gtab + ((type & 1) + ((type >> 2) << 1)) * 128 + wc * 32 + 8 * fq;
            const f32x4 g0 = *(const f32x4*)(gp), g1 = *(const f32x4*)(gp + 4);
            const float invn = isdiff ? (1.0f / 64.0f) : (1.0f / 128.0f);
#pragma unroll
            for (int ai = 0; ai < 2; ++ai)
#pragma unroll
                for (int m = 0; m < 4; ++m) { const int rl = ai * HALF + wr * 64 + m * 16 + fr; const unsigned vo = voff + (unsigned)((ai * HALF + m * 16) * 256);
#pragma unroll
                    for (int bj = 0; bj < 2; ++bj) {
                        const f32x4 pr = *(const PG8_LAS f32x4*)(red + rl * 8 + bj * 4);
                        const float ss = isdiff ? ((wc < 2) ? (pr[0] + pr[1]) : (pr[2] + pr[3])) : ((pr[0] + pr[1]) + (pr[2] + pr[3]));
                        const float rstd = __builtin_amdgcn_rsqf(ss * invn + 1e-6f);
                        *(u32x4*)((bj ? Ot1 : (unsigned char*)Ot) + vo) = pack8(acc[ai][bj][m][0] * g0 * rstd, acc[ai][bj][m][1] * g1 * rstd);
                    } }
        }
    }
};

struct EpiOut {
    static constexpr bool PERM = true, AFTER_DRAIN = false;
    const float* x; bf16_t* a2; float* sumsq;
    __device__ __forceinline__ void operator()(const f32x4 (&acc)[2][2][4][2], const Unit& u, int wr, int wc, int fr, int fq) const {
        const int row0 = u.pm * BM + wr * 64 + fr, col0 = u.pn * BM + wc * 32 + 8 * fq;
#pragma unroll
        for (int ai = 0; ai < 2; ++ai) {
            f32x4 xr[4][2][2];
#pragma unroll
            for (int m = 0; m < 4; ++m)
#pragma unroll
                for (int bj = 0; bj < 2; ++bj) { const size_t off = (size_t)(row0 + ai * HALF + m * 16) * 2048 + col0 + bj * HALF;
                    xr[m][bj][0] = *(const f32x4*)(x + off); xr[m][bj][1] = *(const f32x4*)(x + off + 4); }
            asm volatile("" ::: "memory");
#pragma unroll
            for (int m = 0; m < 4; ++m) { const int row = row0 + ai * HALF + m * 16; float ss = 0.f;
#pragma unroll
                for (int bj = 0; bj < 2; ++bj) { const size_t off = (size_t)row * 2048 + col0 + bj * HALF;
                    const f32x4 h0 = xr[m][bj][0] + acc[ai][bj][m][0], h1 = xr[m][bj][1] + acc[ai][bj][m][1];
                    ss += dot4(h0) + dot4(h1);
                    *(u32x4*)(a2 + off) = pack8(h0, h1); }
                ss += __shfl_xor(ss, 16); ss += __shfl_xor(ss, 32);
                if (fq == 0) atomicAdd(sumsq + row, ss); }
        }
    }
};

struct EpiGate {
    static constexpr bool PERM = true, AFTER_DRAIN = false;
    float* out; const bf16_t* h; const bf16_t* e; const float* sumsq;
    __device__ __forceinline__ void operator()(const f32x4 (&acc)[2][2][4][2], const Unit& u, int wr, int wc, int fr, int fq) const {
        const int row0 = u.pm * BM + wr * 64 + fr, col0 = u.pn * BM + wc * 32 + 8 * fq;
#pragma unroll
        for (int ai = 0; ai < 2; ++ai) {
            u32x4 hv[4][2], ev[4][2]; float sq[4];
#pragma unroll
            for (int m = 0; m < 4; ++m) { const int row = row0 + ai * HALF + m * 16; sq[m] = sumsq[row];
#pragma unroll
                for (int bj = 0; bj < 2; ++bj) { const size_t off = (size_t)row * 2048 + col0 + bj * HALF; hv[m][bj] = *(const u32x4*)(h + off); ev[m][bj] = *(const u32x4*)(e + off); } }
            asm volatile("" ::: "memory");
#pragma unroll
            for (int m = 0; m < 4; ++m) { const int row = row0 + ai * HALF + m * 16;
                const float nr = -LOG2E * __builtin_amdgcn_rsqf(sq[m] * (1.0f / 2048.0f) + 1e-6f);
#pragma unroll
                for (int bj = 0; bj < 2; ++bj) { const size_t off = (size_t)row * 2048 + col0 + bj * HALF;
                    f32x4 h0, h1;
#pragma unroll
                    for (int k = 0; k < 2; ++k) { h0[2 * k] = __uint_as_float(hv[m][bj][k] << 16); h0[2 * k + 1] = __uint_as_float(hv[m][bj][k] & 0xffff0000u);
                        h1[2 * k] = __uint_as_float(hv[m][bj][2 + k] << 16); h1[2 * k + 1] = __uint_as_float(hv[m][bj][2 + k] & 0xffff0000u); }
                    float ef[8];
#pragma unroll
                    for (int k = 0; k < 4; ++k) { ef[2 * k] = __uint_as_float(ev[m][bj][k] << 16); ef[2 * k + 1] = __uint_as_float(ev[m][bj][k] & 0xffff0000u); }
#pragma unroll
                    for (int k = 0; k < 4; ++k) {
                        h0[k] += ef[k] * __builtin_amdgcn_rcpf(1.0f + __builtin_amdgcn_exp2f(acc[ai][bj][m][0][k] * nr));
                        h1[k] += ef[4 + k] * __builtin_amdgcn_rcpf(1.0f + __builtin_amdgcn_exp2f(acc[ai][bj][m][1][k] * nr)); }
                    *(f32x4*)(out + off) = h0; *(f32x4*)(out + off + 4) = h1; } }
        }
    }
};

template <class Epi, class Sched, bool ALIGN_EPI = false, bool SP2 = false>
__device__ __forceinline__ void gemm_phase(PG8_LAS unsigned char* lds, const Gemm g, const Sched& S, const Epi& E) {
    int tid_ = threadIdx.x; asm volatile("" : "+v"(tid_));
    const int tid = tid_, wid = __builtin_amdgcn_readfirstlane(tid >> 6), lane = tid & 63, wr = wid >> 2, wc = wid & 3, fr = lane & 15, fq = lane >> 4;
    int K_ = g.K; asm volatile("" : "+s"(K_)); const int K = K_, nt = K / BK;
    unsigned voffA[2], voffB[2];
#pragma unroll
    for (int i = 0; i < 2; ++i) { int R, C; stage_rc(tid * 16 + i * 8192, R, C); const int Rb = Epi::PERM ? ((R & ~31) + perm32(R & 31)) : R;
        voffA[i] = (unsigned)(R * K + C) * 2u; voffB[i] = (unsigned)(Rb * K + C) * 2u; }
    const size_t kstep = (size_t)(BK * 2);
    const size_t hstep = (size_t)HALF * K * 2;
    const size_t tstep = 2 * hstep;
    const unsigned ldsw = (unsigned)wid * 1024u;
    const int aoff = lds_byte(wr * 64 + fr, fq * 8), boff = lds_byte(wc * 32 + fr, fq * 8);
#define PG8_SA(b, h) (((b) * 2 + (h)) * HTB)
#define PG8_SB(b, h) ((4 + (b) * 2 + (h)) * HTB)
#define PG8_STAGE(bufoff, gbase, voff) do { _Pragma("unroll") for (int _i = 0; _i < 2; ++_i) \
        __builtin_amdgcn_global_load_lds((const unsigned*)((const char*)(gbase) + (voff)[_i]), (PG8_LAS unsigned*)(lds + (bufoff) + ldsw + _i * 8192), 16, 0, 0); } while (0)
#define PG8_LDA(dst, b, h) do { _Pragma("unroll") for (int m = 0; m < 4; ++m) _Pragma("unroll") for (int k = 0; k < 2; ++k) dst[m][k] = *(const PG8_LAS bf16x8*)(lds + PG8_SA(b, h) + aoff + m * 2048 + k * 1024); } while (0)
#define PG8_LDB(dst, b, h) do { _Pragma("unroll") for (int n = 0; n < 2; ++n) _Pragma("unroll") for (int k = 0; k < 2; ++k) dst[n][k] = *(const PG8_LAS bf16x8*)(lds + PG8_SB(b, h) + boff + n * 2048 + k * 1024); } while (0)
#define PG8_MMA(ai, bj, At, Bt) do { __builtin_amdgcn_s_setprio(1); _Pragma("unroll") for (int m = 0; m < 4; ++m) _Pragma("unroll") for (int n = 0; n < 2; ++n) _Pragma("unroll") for (int k = 0; k < 2; ++k) \
        acc[ai][bj][m][n] = __builtin_amdgcn_mfma_f32_16x16x32_bf16(Bt[n][k], At[m][k], acc[ai][bj][m][n], 0, 0, 0); __builtin_amdgcn_s_setprio(0); } while (0)
#define PG8_WAIT_V(n) asm volatile("s_waitcnt vmcnt(" #n ")" ::: "memory")
#define PG8_WAIT_L(n) asm volatile("s_waitcnt lgkmcnt(" #n ")" ::: "memory")
#define PG8_BAR __builtin_amdgcn_s_barrier()
#define PG8_SCHED __builtin_amdgcn_sched_barrier(0)
    Unit cur, nxt; int ui = 0;
    if (!S.next(0, cur)) return;
    f32x4 acc[2][2][4][2];
#pragma unroll
    for (int a = 0; a < 2; ++a)
#pragma unroll
        for (int b = 0; b < 2; ++b)
#pragma unroll
            for (int m = 0; m < 4; ++m)
#pragma unroll
                for (int n = 0; n < 2; ++n) acc[a][b][m][n] = (f32x4){0.f, 0.f, 0.f, 0.f};
    bf16x8 At[4][2], B0[2][2], B1[2][2];
    const char* cA = (const char*)g.A + (size_t)cur.pm * tstep; const char* cB = (const char*)g.Bt + (size_t)cur.pn * tstep;
    S.a_ready(cur);
    if constexpr (SP2) {
        PG8_STAGE(PG8_SB(0, 0), cB, voffB); PG8_STAGE(PG8_SB(0, 1), cB + hstep, voffB); PG8_STAGE(PG8_SA(0, 0), cA, voffA); PG8_STAGE(PG8_SA(0, 1), cA + hstep, voffA);
        if (wr == 1) PG8_BAR;
        PG8_WAIT_V(2); PG8_BAR;
        PG8_STAGE(PG8_SB(1, 0), cB + kstep, voffB); PG8_STAGE(PG8_SA(1, 0), cA + kstep, voffA); PG8_STAGE(PG8_SB(1, 1), cB + hstep + kstep, voffB);
        PG8_WAIT_V(6); PG8_BAR;
    } else {
        PG8_STAGE(PG8_SB(0, 0), cB, voffB); PG8_STAGE(PG8_SA(0, 0), cA, voffA); PG8_STAGE(PG8_SB(0, 1), cB + hstep, voffB); PG8_STAGE(PG8_SA(0, 1), cA + hstep, voffA);
        if (wr == 1) PG8_BAR;
        PG8_WAIT_V(4); PG8_BAR;
        PG8_STAGE(PG8_SB(1, 0), cB + kstep, voffB); PG8_STAGE(PG8_SA(1, 0), cA + kstep, voffA); PG8_STAGE(PG8_SB(1, 1), cB + hstep + kstep, voffB);
        PG8_WAIT_V(6); PG8_BAR;
    }
    for (;;) {
        const bool has_next = S.next(ui + 1, nxt);
        const char* nA = has_next ? (const char*)g.A + (size_t)nxt.pm * tstep : cA; const char* nB = has_next ? (const char*)g.Bt + (size_t)nxt.pn * tstep : cB;
        for (int t = 0; t < nt; t += 2) {
            const bool last = (t == nt - 2);
            const char* a1 = cA + (size_t)(t + 1) * kstep;
            const char* a2 = last ? nA : cA + (size_t)(t + 2) * kstep; const char* b2 = last ? nB : cB + (size_t)(t + 2) * kstep;
            const char* a3 = a2 + kstep; const char* b3 = b2 + kstep;
            if (last && has_next) S.a_ready(nxt);
            if constexpr (SP2) {
            PG8_LDB(B0, 0, 0); PG8_LDB(B1, 0, 1); PG8_SCHED; PG8_LDA(At, 0, 0); PG8_STAGE(PG8_SA(1, 1), a1 + hstep, voffA);
            PG8_WAIT_V(8); PG8_WAIT_L(0); PG8_BAR; PG8_MMA(0, 0, At, B0); PG8_MMA(0, 1, At, B1); PG8_BAR; PG8_SCHED;
            PG8_LDA(At, 0, 1); PG8_STAGE(PG8_SB(0, 0), b2, voffB); PG8_STAGE(PG8_SB(0, 1), b2 + hstep, voffB); PG8_STAGE(PG8_SA(0, 0), a2, voffA);
            PG8_WAIT_V(8); PG8_WAIT_L(0); PG8_BAR; PG8_MMA(1, 0, At, B0); PG8_MMA(1, 1, At, B1); PG8_BAR; PG8_SCHED;
            PG8_LDB(B0, 1, 0); PG8_LDB(B1, 1, 1); PG8_SCHED; PG8_LDA(At, 1, 0); PG8_STAGE(PG8_SA(0, 1), a2 + hstep, voffA);
            PG8_WAIT_V(8); PG8_WAIT_L(0); PG8_BAR; PG8_MMA(0, 0, At, B0); PG8_MMA(0, 1, At, B1); PG8_BAR; PG8_SCHED;
            PG8_LDA(At, 1, 1); PG8_STAGE(PG8_SB(1, 0), b3, voffB); PG8_STAGE(PG8_SB(1, 1), b3 + hstep, voffB); PG8_STAGE(PG8_SA(1, 0), a3, voffA);
            PG8_WAIT_V(8); PG8_WAIT_L(0); PG8_BAR; PG8_MMA(1, 0, At, B0); PG8_MMA(1, 1, At, B1); PG8_BAR; PG8_SCHED;
            } else {
            PG8_LDB(B0, 0, 0); PG8_SCHED; PG8_LDA(At, 0, 0); PG8_STAGE(PG8_SA(1, 1), a1 + hstep, voffA);
            PG8_WAIT_L(8); PG8_BAR; PG8_WAIT_L(0); PG8_MMA(0, 0, At, B0); PG8_BAR; PG8_SCHED;
            PG8_LDB(B1, 0, 1); PG8_STAGE(PG8_SB(0, 0), b2, voffB);
            PG8_BAR; PG8_WAIT_L(0); PG8_MMA(0, 1, At, B1); PG8_BAR;
            PG8_LDA(At, 0, 1); PG8_STAGE(PG8_SA(0, 0), a2, voffA);
            PG8_BAR; PG8_WAIT_L(0); PG8_MMA(1, 0, At, B0); PG8_BAR; PG8_SCHED;
            PG8_STAGE(PG8_SB(0, 1), b2 + hstep, voffB);
            PG8_WAIT_V(6); PG8_BAR; PG8_MMA(1, 1, At, B1); PG8_BAR;
            PG8_LDB(B0, 1, 0); PG8_SCHED; PG8_LDA(At, 1, 0); PG8_STAGE(PG8_SA(0, 1), a2 + hstep, voffA);
            PG8_WAIT_L(8); PG8_BAR; PG8_WAIT_L(0); PG8_MMA(0, 0, At, B0); PG8_BAR; PG8_SCHED;
            PG8_LDB(B1, 1, 1); PG8_STAGE(PG8_SB(1, 0), b3, voffB);
            PG8_BAR; PG8_WAIT_L(0); PG8_MMA(0, 1, At, B1); PG8_BAR;
            PG8_LDA(At, 1, 1); PG8_STAGE(PG8_SA(1, 0), a3, voffA);
            PG8_BAR; PG8_WAIT_L(0); PG8_MMA(1, 0, At, B0); PG8_BAR; PG8_SCHED;
            PG8_STAGE(PG8_SB(1, 1), b3 + hstep, voffB);
            PG8_WAIT_V(6); PG8_BAR; PG8_MMA(1, 1, At, B1); PG8_BAR;
            }
        }
        if constexpr (ALIGN_EPI) { if (wr == 0) PG8_BAR; }
        if constexpr (!Epi::AFTER_DRAIN) { E(acc, cur, wr, wc, fr, fq); S.done(cur); }
        if (!has_next) break;
#pragma unroll
        for (int a = 0; a < 2; ++a)
#pragma unroll
            for (int b = 0; b < 2; ++b)
#pragma unroll
                for (int m = 0; m < 4; ++m)
#pragma unroll
                    for (int n = 0; n < 2; ++n) acc[a][b][m][n] = (f32x4){0.f, 0.f, 0.f, 0.f};
        cur = nxt; cA = nA; cB = nB; ++ui;
        if constexpr (ALIGN_EPI) { if (wr == 1) PG8_BAR; }
    }
    PG8_WAIT_V(0);
    if constexpr (!ALIGN_EPI) { if (wr == 0) PG8_BAR; }
    PG8_BAR;
    if constexpr (Epi::AFTER_DRAIN) { E.fused(acc, cur, wr, wc, fr, fq, lds, wid, lane); S.done(cur); }
#undef PG8_SA
#undef PG8_SB
#undef PG8_STAGE
#undef PG8_LDA
#undef PG8_LDB
#undef PG8_MMA
#undef PG8_WAIT_V
#undef PG8_WAIT_L
#undef PG8_BAR
#undef PG8_SCHED
}
}
#define LAS __attribute__((address_space(3)))
typedef unsigned short bf16_t;
typedef short bf16x8 __attribute__((ext_vector_type(8)));
typedef short s16x4 __attribute__((ext_vector_type(4)));
typedef float f32x4 __attribute__((ext_vector_type(4)));
typedef float f32x16 __attribute__((ext_vector_type(16)));
typedef unsigned u32x4 __attribute__((ext_vector_type(4)));
typedef unsigned u32x2 __attribute__((ext_vector_type(2)));
using pg8::cvt_pk_bf16;

constexpr int B_ = 4, S_ = 8192, DM = 2048, M_ = B_ * S_, NP = 8192, INW = 8200, PLE = 256, NT = 512;
constexpr int LDS_BYTES = 144 * 1024;
constexpr size_t WS_CTL = 0, WS_TAB = 4096, WS_SUMSQ = 16384, WS_LOGF = WS_SUMSQ + 131072, WS_C = WS_LOGF + (1u << 20), WS_WIN = WS_C + (1u << 20);
constexpr size_t WS_WOUT = WS_WIN + (size_t)NP * DM * 2, WS_WG = WS_WOUT + (size_t)DM * DM * 2, WS_WP = WS_WG + (size_t)DM * DM * 2, WS_PB = WS_WP + (size_t)DM * PLE * 2;
constexpr size_t WS_U = WS_PB + (size_t)M_ * PLE * 2, WS_E = WS_U + (size_t)M_ * DM * 2, WS_QKVZ = WS_E + (size_t)M_ * DM * 2, WS_END = WS_QKVZ + (size_t)M_ * NP * 2;
constexpr size_t WS_BAR = WS_END, WS_TOTAL = WS_END + 16384;
constexpr size_t WS_MIX = WS_U;
constexpr size_t WS_A2 = WS_QKVZ;
constexpr int TAB_LAM = 1056, TAB_AQ2 = 1057, TAB_DBOUND = 1058, TAB_GAIN = 1088;
constexpr int QN = 384;

struct Params { const float* in[19]; float* out; unsigned char* ws; };
enum { I_X = 0, I_P, I_ATTN_NORM, I_W_IN, I_B_FORGET, I_FQN, I_FKN, I_DQN, I_DKN, I_LQ1, I_LK1, I_LQ2, I_LK2, I_DON, I_W_OUT, I_REL_BIAS, I_PLE_PROJ, I_PGN, I_PLE_GATE };

__device__ __forceinline__ float wave_sum(float v) {
#pragma unroll
    for (int o = 32; o >= 1; o >>= 1) v += __shfl_xor(v, o);
    return v;
}
__device__ __forceinline__ float wave_max(float v) {
#pragma unroll
    for (int o = 32; o >= 1; o >>= 1) v = fmaxf(v, __shfl_xor(v, o));
    return v;
}
__device__ __forceinline__ float silu_f(float z) { return z * __builtin_amdgcn_rcpf(1.0f + __builtin_amdgcn_exp2f(-LOG2E * z)); }
__device__ __forceinline__ float bf_lo(unsigned v) { return __uint_as_float(v << 16); }
__device__ __forceinline__ float bf_hi(unsigned v) { return __uint_as_float(v & 0xffff0000u); }

__device__ __forceinline__ void transpose_tile_wave(const float* W, int ldw, int K, bf16_t* Wt, int kt, int ntile, LAS float* tile, int lane, const float* kscale = nullptr) {
    const int k0 = kt * 64, n0 = ntile * 64, kr = lane >> 4, n4 = (lane & 15) * 4;
#pragma unroll
    for (int h = 0; h < 2; ++h) { f32x4 v[8];
#pragma unroll
        for (int i = 0; i < 8; ++i) v[i] = *(const f32x4*)(W + (size_t)(k0 + (h * 8 + i) * 4 + kr) * ldw + n0 + n4);
#pragma unroll
        for (int i = 0; i < 8; ++i) *(LAS f32x4*)(tile + ((h * 8 + i) * 4 + kr) * 68 + n4) = v[i]; }
    asm volatile("s_waitcnt lgkmcnt(0)" ::: "memory");
#pragma unroll
    for (int kc = 0; kc < 8; ++kc) { float v[8];
#pragma unroll
        for (int j = 0; j < 8; ++j) v[j] = tile[(kc * 8 + j) * 68 + lane];
        if (kscale) {
#pragma unroll
            for (int j = 0; j < 8; ++j) v[j] *= kscale[k0 + kc * 8 + j]; }
        u32x4 w; w.x = cvt_pk_bf16(v[0], v[1]); w.y = cvt_pk_bf16(v[2], v[3]); w.z = cvt_pk_bf16(v[4], v[5]); w.w = cvt_pk_bf16(v[6], v[7]);
        *(u32x4*)(Wt + (size_t)(n0 + lane) * K + k0 + kc * 8) = w; }
    asm volatile("s_waitcnt lgkmcnt(0)" ::: "memory");
}

__device__ __forceinline__ void p0_prologue(const Params& P, LAS unsigned char* lds) {
    int tid_ = threadIdx.x; asm volatile("" : "+v"(tid_)); const int tid = tid_, lane = tid & 63, wid = tid >> 6, G = gridDim.x, bx = blockIdx.x;
    unsigned char* ws = P.ws;
    float* tab = (float*)(ws + WS_TAB);
    if (bx == 0) {
        if (tid < 64) ((unsigned*)(ws + WS_CTL))[tid] = 0u;
        for (int i = tid; i < 3456  ; i += NT) ((unsigned*)(ws + WS_BAR))[i] = 0u;
        for (int idx = tid; idx < 8 * 129; idx += NT) { const int h = idx / 129, d = idx % 129; int bk;
            if (d < 16) bk = d; else bk = 15 + (d >= 16) + (d >= 19) + (d >= 21) + (d >= 24) + (d >= 27) + (d >= 31) + (d >= 35) + (d >= 40) + (d >= 46) + (d >= 52) + (d >= 59) + (d >= 67) + (d >= 77) + (d >= 87) + (d >= 99) + (d >= 113);
            tab[h * 132 + d] = P.in[I_REL_BIAS][bk * 8 + h] * LOG2E; }
        { const int c = tid & 127, t = tid >> 7;
          const float gv = (t == 0) ? P.in[I_FQN][c] * (0.08838834764831845f * LOG2E) : (t == 1) ? P.in[I_FKN][c] : (t == 2) ? P.in[I_DQN][c & 63] * (0.125f * LOG2E) : P.in[I_DKN][c & 63];
          tab[TAB_GAIN + tid] = gv; }
        if (wid == 0) { const float s1 = wave_sum(P.in[I_LQ1][lane] * P.in[I_LK1][lane]), s2 = wave_sum(P.in[I_LQ2][lane] * P.in[I_LK2][lane]);
            if (lane == 0) tab[TAB_LAM] = expf(s1) - expf(s2) + 0.2f; }
        if (wid == 1) { const float gq = wave_max(fmaxf(fabsf(P.in[I_FQN][lane]), fabsf(P.in[I_FQN][lane + 64]))), gk = wave_max(fmaxf(fabsf(P.in[I_FKN][lane]), fabsf(P.in[I_FKN][lane + 64])));
            if (lane == 0) tab[TAB_AQ2] = 2.0f * 128.0f * (0.08838834764831845f * LOG2E) * gq * gk * 1.03f; }
        if (wid == 2) {
            const float gq = wave_max(fabsf(P.in[I_DQN][lane])), gk = wave_max(fabsf(P.in[I_DKN][lane]));
            float bm = 0.f;
            for (int i = lane; i < 256; i += 64) bm = fmaxf(bm, fabsf(P.in[I_REL_BIAS][i]));
            bm = wave_max(bm);
            if (lane == 0) tab[TAB_DBOUND] = 64.0f * (0.125f * LOG2E) * gq * gk * 1.03f + 2.0f * LOG2E * bm; }
    }
    { float* sumsq = (float*)(ws + WS_SUMSQ); for (int i = bx * NT + tid; i < M_; i += G * NT) sumsq[i] = 0.f; }
    { const float* p = P.in[I_P]; bf16_t* pb = (bf16_t*)(ws + WS_PB);
      for (int it = bx * NT + tid; it < M_ * PLE / 8; it += 4 * G * NT) { f32x4 a[4], b[4];
#pragma unroll
          for (int k = 0; k < 4; ++k) { const int itk = it + k * G * NT; if (itk < M_ * PLE / 8) { a[k] = *(const f32x4*)(p + (size_t)itk * 8); b[k] = *(const f32x4*)(p + (size_t)itk * 8 + 4); } }
          asm volatile("" ::: "memory");
#pragma unroll
          for (int k = 0; k < 4; ++k) { const int itk = it + k * G * NT; if (itk < M_ * PLE / 8) *(u32x4*)(pb + (size_t)itk * 8) = pg8::pack8(a[k], b[k]); } } }
    { LAS float* mytile = (LAS float*)(lds + wid * (64 * 68 * 4));
      for (int t = bx * 8 + wid; t < 6272; t += G * 8) {
        if (t < 4096) transpose_tile_wave(P.in[I_W_IN], INW, DM, (bf16_t*)(ws + WS_WIN), t & 31, t >> 5, mytile, lane);
        else if (t < 5120) transpose_tile_wave(P.in[I_W_OUT], DM, DM, (bf16_t*)(ws + WS_WOUT), (t - 4096) & 31, (t - 4096) >> 5, mytile, lane);
        else if (t < 6144) transpose_tile_wave(P.in[I_PLE_GATE], DM, DM, (bf16_t*)(ws + WS_WG), (t - 5120) & 31, (t - 5120) >> 5, mytile, lane, P.in[I_PGN]);
        else transpose_tile_wave(P.in[I_PLE_PROJ], DM, PLE, (bf16_t*)(ws + WS_WP), (t - 6144) & 3, (t - 6144) >> 2, mytile, lane);
      } }
    __syncthreads();
    LAS float* wf = (LAS float*)lds;
    for (int i = tid; i < 8 * DM; i += NT) { const int j = i & 7, d = i >> 3; wf[j * DM + d] = P.in[I_W_IN][(size_t)d * INW + NP + j]; }
    __syncthreads();
    const float* x = P.in[I_X]; const float* gain = P.in[I_ATTN_NORM]; bf16_t* U = (bf16_t*)(ws + WS_U); float* logf_ = (float*)(ws + WS_LOGF);
    const float bfg = P.in[I_B_FORGET][lane & 7];
    f32x4 gvec[8];
#pragma unroll
    for (int i = 0; i < 8; ++i) gvec[i] = *(const f32x4*)(gain + 256 * i + 4 * lane);
    f32x4 nx[8], nx2[8];
    { const float* xr0 = x + (size_t)(bx * 8 + wid) * DM; const float* xr1 = x + (size_t)((bx + G) * 8 + wid) * DM;
#pragma unroll
      for (int i = 0; i < 8; ++i) nx[i] = *(const f32x4*)(xr0 + 256 * i + 4 * lane);
      if (bx + G < M_ / 8) {
#pragma unroll
        for (int i = 0; i < 8; ++i) nx2[i] = *(const f32x4*)(xr1 + 256 * i + 4 * lane); } }
#pragma unroll 2
    for (int rg = bx; rg < M_ / 8; rg += G) {
        const int row = rg * 8 + wid;
        f32x4 y[8]; float ss = 0.f;
#pragma unroll
        for (int i = 0; i < 8; ++i) { y[i] = nx[i]; ss += pg8::dot4(y[i]); nx[i] = nx2[i]; }
        if (rg + 2 * G < M_ / 8) { const float* xn = x + (size_t)((rg + 2 * G) * 8 + wid) * DM;
#pragma unroll
            for (int i = 0; i < 8; ++i) nx2[i] = *(const f32x4*)(xn + 256 * i + 4 * lane); }
        ss = wave_sum(ss);
        const float rstd = 1.0f / sqrtf(ss * (1.0f / 2048.0f) + 1e-6f);
#pragma unroll
        for (int i = 0; i < 8; ++i) { y[i] = y[i] * rstd * gvec[i];
            u32x2 w; w.x = cvt_pk_bf16(y[i][0], y[i][1]); w.y = cvt_pk_bf16(y[i][2], y[i][3]); *(u32x2*)(U + (size_t)row * DM + 256 * i + 4 * lane) = w; }
        float fmine = 0.f;
#pragma unroll 1
        for (int j = 0; j < 8; ++j) { float fa = 0.f;
#pragma unroll
            for (int i = 0; i < 8; ++i) { const f32x4 wv = *(const LAS f32x4*)(wf + j * DM + 256 * i + 4 * lane); fa += (y[i][0] * wv[0] + y[i][1] * wv[1]) + (y[i][2] * wv[2] + y[i][3] * wv[3]); }
            fa = wave_sum(fa);
            fmine = (lane == j) ? fa : fmine; }
        if (lane < 8) { float z = fmine + bfg;
            const float lf = fminf(z, 0.f) - log1pf(expf(-fabsf(z)));
            const int b = row / S_, s = row % S_;
            logf_[(size_t)(b * 8 + lane) * S_ + s] = lf; }
    }
    __syncthreads();
}

__device__ __forceinline__ void cumsum_seq(const Params& P, LAS unsigned char* lds, int seq) {
    int tid_ = threadIdx.x; asm volatile("" : "+v"(tid_)); const int tid = tid_, lane = tid & 63, wid = tid >> 6;
    const float* src = (const float*)(P.ws + WS_LOGF) + (size_t)seq * S_ + tid * 16; float* dst = (float*)(P.ws + WS_C) + (size_t)seq * S_ + tid * 16;
    float v[16];
#pragma unroll
    for (int i = 0; i < 4; ++i) { const f32x4 t = *(const f32x4*)(src + 4 * i); v[4 * i] = t[0]; v[4 * i + 1] = t[1]; v[4 * i + 2] = t[2]; v[4 * i + 3] = t[3]; }
#pragma unroll
    for (int i = 1; i < 16; ++i) v[i] += v[i - 1];
    float tot = v[15], inc = tot;
#pragma unroll
    for (int o = 1; o < 64; o <<= 1) { const float t = __shfl_up(inc, o); if (lane >= o) inc += t; }
    LAS float* wt = (LAS float*)lds;
    if (lane == 63) wt[wid] = inc;
    __syncthreads();
    float pre = inc - tot;
    for (int k = 0; k < wid; ++k) pre += wt[k];
#pragma unroll
    for (int i = 0; i < 4; ++i) { f32x4 t; t[0] = (v[4 * i] + pre) * LOG2E; t[1] = (v[4 * i + 1] + pre) * LOG2E; t[2] = (v[4 * i + 2] + pre) * LOG2E; t[3] = (v[4 * i + 3] + pre) * LOG2E; *(f32x4*)(dst + 4 * i) = t; }
    __syncthreads();
}
#define XB_TMO      128
#define XB_XCNT(j)  (256  + 64 * (j))
#define XB_XSUB(j)  (1280 + 64 * (j))
#define XB_XGEN(j)  (2304 + 64 * (j))
#define XB_TOP      3328
#define XB_TOPGEN   3392
#define XCD_BAR_WORDS 3456
#define XB_SPIN_CAP (1u << 22)

__device__ __forceinline__ unsigned xb_ld(unsigned* p)              { return __hip_atomic_load(p, __ATOMIC_RELAXED, __HIP_MEMORY_SCOPE_AGENT); }
__device__ __forceinline__ unsigned xb_add(unsigned* p, unsigned v) { return __hip_atomic_fetch_add(p, v, __ATOMIC_RELAXED, __HIP_MEMORY_SCOPE_AGENT); }
__device__ __forceinline__ unsigned xb_xcc_id() { return (unsigned)__builtin_amdgcn_s_getreg((3 << 11) | 20) & 0xFu; }
#define XB_SPIN(cond, bar) do { unsigned _sp = 0; while (cond) { __builtin_amdgcn_s_sleep(1); \
    if ((++_sp & 255u) == 0u) { if (xb_ld(&(bar)[XB_TMO])) break; if (_sp > XB_SPIN_CAP) { atomicAdd(&(bar)[XB_TMO], 1u); break; } } } } while (0)

struct XcdBarrier {
    unsigned* bar; unsigned x;
    volatile LAS unsigned* st;
};

__device__ __forceinline__ XcdBarrier xcd_barrier_post(unsigned* bar, volatile LAS unsigned* st) {
    XcdBarrier b; b.bar = bar; b.x = xb_xcc_id(); b.st = st;
    if (threadIdx.x == 0) (void)xb_add(&bar[XB_XCNT(b.x)], 1u);
    return b;
}
__device__ __forceinline__ void xcd_barrier_complete(unsigned* bar, unsigned x, unsigned& nloc, unsigned& nx) {
    const unsigned G = gridDim.x * gridDim.y * gridDim.z;
    unsigned sum, cnt, mine, sp = 0u;
    for (;;) {
        sum = 0u; cnt = 0u; mine = 0u;
#pragma unroll
        for (unsigned j = 0; j < 16; ++j) { const unsigned c = xb_ld(&bar[XB_XCNT(j)]); sum += c; cnt += (c > 0u) ? 1u : 0u; mine = (j == x) ? c : mine; }
        if (sum == G) break;
        __builtin_amdgcn_s_sleep(1);
        if ((++sp & 255u) == 0u) { if (xb_ld(&bar[XB_TMO])) break; if (sp > XB_SPIN_CAP) { atomicAdd(&bar[XB_TMO], 1u); break; } }
    }
    nloc = mine > 0u ? mine : 1u; nx = cnt > 0u ? cnt : 1u;
}

__device__ __forceinline__ void xcd_barrier(const XcdBarrier& b) {
    asm volatile("s_waitcnt vmcnt(0)" ::: "memory");
    __syncthreads();
    if (threadIdx.x == 0) {
        unsigned* bar = b.bar;
        __builtin_amdgcn_s_waitcnt(0);
        unsigned nloc = b.st[0], nx = b.st[1];
        if (nloc == 0u) { xcd_barrier_complete(bar, b.x, nloc, nx); b.st[0] = nloc; b.st[1] = nx; }
        const unsigned old = xb_add(&bar[XB_XSUB(b.x)], 1u);
        const unsigned gen = old / nloc;
        if (old + 1u == (gen + 1u) * nloc) {
            __builtin_amdgcn_fence(__ATOMIC_RELEASE, "agent");
            asm volatile("s_waitcnt vmcnt(0)" ::: "memory");
            const unsigned og = xb_add(&bar[XB_TOP], 1u);
            const unsigned tg = og / nx;
            if (og + 1u == (tg + 1u) * nx) xb_add(&bar[XB_TOPGEN], 1u);
            else XB_SPIN(xb_ld(&bar[XB_TOPGEN]) == tg, bar);
            __builtin_amdgcn_fence(__ATOMIC_ACQUIRE, "agent");
            xb_add(&bar[XB_XGEN(b.x)], 1u);
            asm volatile("s_waitcnt vmcnt(0)" ::: "memory");
        } else {
            XB_SPIN(xb_ld(&bar[XB_XGEN(b.x)]) == gen, bar);
            __builtin_amdgcn_fence(__ATOMIC_ACQUIRE, "agent");
            asm volatile("s_waitcnt vmcnt(0)" ::: "memory");
        }
    }
    __syncthreads();
}


#define MFMA32(a, b, c) __builtin_amdgcn_mfma_f32_32x32x16_bf16((a), (b), (c), 0, 0, 0)
constexpr int AL_NBUF = 4, AL_PD = 3, AL_CLS = 131072, AL_MISC = AL_CLS + 8192, AL_BIAS = AL_MISC + 256;
#define ATT_WAITV(n) asm volatile("s_waitcnt vmcnt(" #n ")" ::: "memory")

template <bool ONLINE, int NO>
__device__ __forceinline__ void softmax_tile(f32x16 (&s)[2], float& m, float& l, f32x16 (&O)[NO], u32x4 (&pk)[4]) {
    float mn = 0.f;
    if (ONLINE) {
        float mx = s[0][0];
#pragma unroll
        for (int i = 1; i < 16; ++i) mx = fmaxf(mx, s[0][i]);
#pragma unroll
        for (int i = 0; i < 16; ++i) mx = fmaxf(mx, s[1][i]);
        mx = fmaxf(mx, __shfl_xor(mx, 32));
        mn = fmaxf(m, mx);
        if (__builtin_amdgcn_ballot_w64(mn > m) != 0ull) {
            const float alpha = __builtin_amdgcn_exp2f(m - mn);
            m = mn; l *= alpha;
#pragma unroll
            for (int d = 0; d < NO; ++d) O[d] = O[d] * alpha;
        }
    }
    float ps = 0.f;
#pragma unroll
    for (int blk = 0; blk < 2; ++blk)
#pragma unroll
        for (int i = 0; i < 16; ++i) { const float p = __builtin_amdgcn_exp2f(ONLINE ? (s[blk][i] - mn) : s[blk][i]); ps += p; s[blk][i] = p; }
    l += ps;
#pragma unroll
    for (int blk = 0; blk < 2; ++blk)
#pragma unroll
        for (int sh = 0; sh < 2; ++sh) { u32x4 pw;
            pw.x = cvt_pk_bf16(s[blk][8 * sh], s[blk][8 * sh + 1]); pw.y = cvt_pk_bf16(s[blk][8 * sh + 2], s[blk][8 * sh + 3]);
            pw.z = cvt_pk_bf16(s[blk][8 * sh + 4], s[blk][8 * sh + 5]); pw.w = cvt_pk_bf16(s[blk][8 * sh + 6], s[blk][8 * sh + 7]); pk[2 * blk + sh] = pw; }
}


template <int G>
__device__ __forceinline__ void v_issue(s16x4 (&v)[8], const unsigned addr) {
    asm volatile("ds_read_b64_tr_b16 %0, %8 offset:%9\n\tds_read_b64_tr_b16 %1, %8 offset:%10\n\tds_read_b64_tr_b16 %2, %8 offset:%11\n\tds_read_b64_tr_b16 %3, %8 offset:%12\n\t"
                 "ds_read_b64_tr_b16 %4, %8 offset:%13\n\tds_read_b64_tr_b16 %5, %8 offset:%14\n\tds_read_b64_tr_b16 %6, %8 offset:%15\n\tds_read_b64_tr_b16 %7, %8 offset:%16"
                 : "=&v"(v[0]), "=&v"(v[1]), "=&v"(v[2]), "=&v"(v[3]), "=&v"(v[4]), "=&v"(v[5]), "=&v"(v[6]), "=&v"(v[7])
                 : "v"(addr), "i"(G * 4096), "i"(G * 4096 + 256), "i"(G * 4096 + 512), "i"(G * 4096 + 768), "i"(G * 4096 + 1024), "i"(G * 4096 + 1280), "i"(G * 4096 + 1536), "i"(G * 4096 + 1792));
}
template <int N>
__device__ __forceinline__ void v_wait(s16x4 (&v)[8]) {
    asm volatile("s_waitcnt lgkmcnt(%8)" : "+v"(v[0]), "+v"(v[1]), "+v"(v[2]), "+v"(v[3]), "+v"(v[4]), "+v"(v[5]), "+v"(v[6]), "+v"(v[7]) : "i"(N));
}
__device__ __forceinline__ void k_issue4(bf16x8 (&k)[8], const unsigned a0, const unsigned a1, const unsigned a2, const unsigned a3) {
    asm volatile("ds_read_b128 %0, %8\n\tds_read_b128 %1, %8 offset:8192\n\tds_read_b128 %2, %9\n\tds_read_b128 %3, %9 offset:8192\n\t"
                 "ds_read_b128 %4, %10\n\tds_read_b128 %5, %10 offset:8192\n\tds_read_b128 %6, %11\n\tds_read_b128 %7, %11 offset:8192"
                 : "=&v"(k[0]), "=&v"(k[1]), "=&v"(k[2]), "=&v"(k[3]), "=&v"(k[4]), "=&v"(k[5]), "=&v"(k[6]), "=&v"(k[7])
                 : "v"(a0), "v"(a1), "v"(a2), "v"(a3));
}
template <int N>
__device__ __forceinline__ void k_wait(bf16x8 (&k)[8]) {
    asm volatile("s_waitcnt lgkmcnt(%8)" : "+v"(k[0]), "+v"(k[1]), "+v"(k[2]), "+v"(k[3]), "+v"(k[4]), "+v"(k[5]), "+v"(k[6]), "+v"(k[7]) : "i"(N));
}
#define ATT_PV(v_, p_) do { const bf16x8 pf_ = __builtin_bit_cast(bf16x8, (p_)); _Pragma("unroll") for (int d = 0; d < 4; ++d) { \
        const bf16x8 vf_ = __builtin_shufflevector((v_)[2 * d], (v_)[2 * d + 1], 0, 1, 2, 3, 4, 5, 6, 7); O[d] = MFMA32(vf_, pf_, O[d]); } } while (0)

template <int MODE>
__device__ __forceinline__ void attn_unit(const Params& P, LAS unsigned char* lds, const int b, const int h, const int qb) {
    constexpr bool FOX = (MODE == 0), ONLINE = (MODE != 1);
    constexpr int ROWS = FOX ? 256 : 128, NQ = FOX ? 8 : 4;
    int tid_ = threadIdx.x; asm volatile("" : "+v"(tid_));
    const int tid = tid_, lane = tid & 63, w = __builtin_amdgcn_readfirstlane(tid >> 6), r = lane & 31, hh = lane >> 5;
    const int mp = FOX ? 0 : (w >> 2);
    const int q0 = qb * ROWS, q0w = q0 + 32 * (FOX ? w : (w & 3)), q = q0w + r;
    bf16_t* QKVZ = (bf16_t*)(P.ws + WS_QKVZ);
    const float* tab = (const float*)(P.ws + WS_TAB);
    const size_t tokbase = (size_t)b * S_;
    const int colO = FOX ? h * 128 : 1024 + h * 128;
    constexpr size_t TS = (size_t)4 * 8 * 8192 * 128;
    const size_t hb = ((size_t)(b * 8 + h)) * 8192 * 128;
    const bf16_t* Qb = QKVZ + (FOX ? 0 : 4) * TS + hb; const bf16_t* Kb_ = QKVZ + (FOX ? 1 : 5) * TS + hb;
    const bf16_t* Vb_ = QKVZ + (FOX ? 2 : 6) * TS + hb; const bf16_t* Zb = QKVZ + (FOX ? 3 : 7) * TS + hb;
    constexpr int RS = 128;
    bf16x8 Qf[NQ];
    { const bf16_t* qp = Qb + (size_t)q * RS + (FOX ? 0 : 64 * mp) + 8 * hh;
#pragma unroll
      for (int ks = 0; ks < NQ; ++ks) Qf[ks] = *(const bf16x8*)(qp + 16 * ks); }
    const int nt = (q0 + ROWS) / 64;
    int kt0 = 0;
    const float* Cl = (const float*)(P.ws + WS_C) + (size_t)(b * 8 + h) * S_;
    if (FOX) {
        const int kd = q0 / 64; int pred = 0;
        if (tid < kd) pred = (tab[TAB_AQ2] + Cl[q0] - Cl[tid * 64 + 63] >= -150.0f) ? 1 : 0;
        kt0 = kd - __syncthreads_count(pred);
    } else {
        if (tid < 129) ((LAS float*)(lds + AL_BIAS))[tid] = tab[h * 132 + tid] - tab[h * 132 + 128];
    }
    const int krow = 4 * w + (lane >> 4), kchunk = (lane & 15) ^ (krow & 15);
    const bf16_t* kg = Kb_ + (size_t)krow * RS + kchunk * 8;
    const int vst = 2 * w + (lane >> 5), vkey = (vst >> 2) * 8 + ((lane >> 2) & 7);
    const bf16_t* vg = Vb_ + (size_t)vkey * RS + (vst & 3) * 32 + (lane & 3) * 8;
    const float* cg_ = Cl + lane;
#define ATT_DMA(kt_, buf_) do { const size_t ro_ = (size_t)((kt_) * 64) * RS; LAS unsigned char* b_ = lds + (buf_) * 32768 + w * 1024; \
        __builtin_amdgcn_global_load_lds((const unsigned*)(kg + ro_), (LAS unsigned*)(b_), 16, 0, 0); \
        __builtin_amdgcn_global_load_lds((const unsigned*)(kg + ro_ + (size_t)32 * RS), (LAS unsigned*)(b_ + 8192), 16, 0, 0); \
        __builtin_amdgcn_global_load_lds((const unsigned*)(vg + ro_), (LAS unsigned*)(b_ + 16384), 16, 0, 0); \
        __builtin_amdgcn_global_load_lds((const unsigned*)(vg + ro_ + (size_t)32 * RS), (LAS unsigned*)(b_ + 16384 + 8192), 16, 0, 0); \
        if (FOX) __builtin_amdgcn_global_load_lds((const unsigned*)(cg_ + (kt_) * 64), (LAS unsigned*)(lds + AL_CLS + ((buf_) * 8 + w) * 256), 4, 0, 0); } while (0)
    const int pr = (r & 19) | ((r & 4) << 1) | ((r & 8) >> 1);
    const unsigned kra = pr * 256, kswz = pr & 15;
    const unsigned vra = 16384 + hh * 2048 + ((lane & 15) >> 2) * 64 + ((lane >> 4) & 1) * 32 + (lane & 3) * 8;
    f32x16 O[4];
#pragma unroll
    for (int d = 0; d < 4; ++d)
#pragma unroll
        for (int i = 0; i < 16; ++i) O[d][i] = 0.f;
    float m1 = ONLINE ? -INFINITY : 0.f, l1 = 0.f;
    const int ktw_last = (q0w + 31) / 64;

    ATT_WAITV(0); __builtin_amdgcn_s_barrier(); asm volatile("" ::: "memory");
#pragma unroll
    for (int i = 0; i < AL_PD; ++i) if (kt0 + i < nt) ATT_DMA(kt0 + i, i);
    for (int kt = kt0; kt < nt; ++kt) {
        const int rel = kt - kt0, cur = rel & (AL_NBUF - 1);
        if (kt + 2 < nt) { if (FOX) ATT_WAITV(10); else ATT_WAITV(8); } else if (kt + 1 < nt) { if (FOX) ATT_WAITV(5); else ATT_WAITV(4); } else ATT_WAITV(0);
        __builtin_amdgcn_s_barrier(); asm volatile("" ::: "memory");
        if (kt + AL_PD < nt) ATT_DMA(kt + AL_PD, (rel + AL_PD) & (AL_NBUF - 1));
        if (kt <= ktw_last) {
            const LAS unsigned char* Kb = lds + cur * 32768;
            const int kbase = kt * 64 + 8 * hh;
            u32x4 pk1[4];
            f32x16 s[2];
#pragma unroll
            for (int i = 0; i < 16; ++i) { s[0][i] = 0.f; s[1][i] = 0.f; }
            s16x4 va[8], vb[8], vc[8], vd[8];
            const unsigned vaddr = (unsigned)(uintptr_t)(Kb + vra);
            if constexpr (MODE == 1) {
                bf16x8 kf[8];
                const unsigned kb_ = (unsigned)(uintptr_t)Kb + kra, c0 = mp * 8 + hh;
                k_issue4(kf, kb_ + (((c0) ^ kswz) << 4), kb_ + (((c0 + 2) ^ kswz) << 4), kb_ + (((c0 + 4) ^ kswz) << 4), kb_ + (((c0 + 6) ^ kswz) << 4));
                v_issue<0>(va, vaddr);
                k_wait<8>(kf);
#pragma unroll
                for (int ks = 0; ks < 4; ++ks) { s[0] = MFMA32(kf[2 * ks], Qf[ks], s[0]); s[1] = MFMA32(kf[2 * ks + 1], Qf[ks], s[1]); }
                v_issue<1>(vb, vaddr);
            } else {
#pragma unroll
            for (int ks = 0; ks < NQ; ++ks) {
                const unsigned chunk = mp * 8 + 2 * ks + hh;
                const unsigned off = kra + ((chunk ^ kswz) << 4);
                const bf16x8 a0 = *(const LAS bf16x8*)(Kb + off), a1 = *(const LAS bf16x8*)(Kb + off + 8192);
                s[0] = MFMA32(a0, Qf[ks], s[0]); s[1] = MFMA32(a1, Qf[ks], s[1]);
            }
            v_issue<0>(va, vaddr);
            }
            if (FOX) {
                const LAS float* cl = (const LAS float*)(lds + AL_CLS + (cur * 8 + w) * 256) + 8 * hh;
#pragma unroll
                for (int blk = 0; blk < 2; ++blk)
#pragma unroll
                    for (int j4 = 0; j4 < 4; ++j4) { const f32x4 c = *(const LAS f32x4*)(cl + 32 * blk + 16 * (j4 >> 1) + 4 * (j4 & 1));
#pragma unroll
                        for (int e = 0; e < 4; ++e) s[blk][4 * j4 + e] -= c[e]; }
            } else if (q0w - kt * 64 - 63 < 128) {
                const LAS float* bl = (const LAS float*)(lds + AL_BIAS);
#pragma unroll
                for (int blk = 0; blk < 2; ++blk)
#pragma unroll
                    for (int i = 0; i < 16; ++i) { const int dist = q - (kbase + 32 * blk + 16 * (i >> 3) + (i & 7)); const int di = dist < 0 ? 0 : (dist > 128 ? 128 : dist); s[blk][i] += bl[di]; }
            }
            if (kt * 64 + 63 > q0w) {
#pragma unroll
                for (int blk = 0; blk < 2; ++blk)
#pragma unroll
                    for (int i = 0; i < 16; ++i) { if (kbase + 32 * blk + 16 * (i >> 3) + (i & 7) > q) s[blk][i] = -INFINITY; }
            }
            softmax_tile<ONLINE, 4>(s, m1, l1, O, pk1);
            if constexpr (MODE == 1) {
                v_issue<2>(vc, vaddr); v_wait<15>(va); ATT_PV(va, pk1[0]); v_issue<3>(vd, vaddr); v_wait<15>(vb); ATT_PV(vb, pk1[1]); v_wait<8>(vc); ATT_PV(vc, pk1[2]); v_wait<0>(vd); ATT_PV(vd, pk1[3]);
            } else {
            v_issue<1>(vb, vaddr); v_wait<8>(va); ATT_PV(va, pk1[0]);
            v_issue<2>(va, vaddr); v_wait<8>(vb); ATT_PV(vb, pk1[1]);
            v_issue<3>(vb, vaddr); v_wait<8>(va); ATT_PV(va, pk1[2]);
            v_wait<0>(vb); ATT_PV(vb, pk1[3]);
            }
        }
    }
#undef ATT_DMA
    bf16_t* mix = (bf16_t*)(P.ws + WS_MIX) + (tokbase + q) * DM + colO;
    const bf16_t* zp = Zb + (size_t)q * RS;
    const float inv1 = 1.0f / (l1 + __shfl_xor(l1, 32));
    u32x2 zv[4][4]; f32x4 gv[4][4];
    if (FOX || mp == 0) {
#pragma unroll
        for (int d = 0; d < 4; ++d)
#pragma unroll
            for (int a = 0; a < 4; ++a) { const int d0 = 32 * d + 8 * a + 4 * hh; zv[d][a] = *(const u32x2*)(zp + d0); if (!FOX) gv[d][a] = *(const f32x4*)(P.in[I_DON] + d0); }
    }
    asm volatile("" ::: "memory");
    if (FOX) {
#pragma unroll
        for (int d = 0; d < 4; ++d)
#pragma unroll
            for (int a = 0; a < 4; ++a) { const int d0 = 32 * d + 8 * a + 4 * hh; const u32x2 z2 = zv[d][a];
                const float o0 = O[d][4 * a] * inv1 * silu_f(bf_lo(z2.x)), o1 = O[d][4 * a + 1] * inv1 * silu_f(bf_hi(z2.x));
                const float o2 = O[d][4 * a + 2] * inv1 * silu_f(bf_lo(z2.y)), o3 = O[d][4 * a + 3] * inv1 * silu_f(bf_hi(z2.y));
                u32x2 ov; ov.x = cvt_pk_bf16(o0, o1); ov.y = cvt_pk_bf16(o2, o3); *(u32x2*)(mix + d0) = ov; }
        __syncthreads();
    } else {
        __syncthreads();
        LAS float* xb = (LAS float*)lds;
        if (mp == 1) {
#pragma unroll
            for (int d = 0; d < 4; ++d)
#pragma unroll
                for (int i = 0; i < 16; ++i) xb[(((w & 3) * 4 + d) * 16 + i) * 64 + lane] = O[d][i] * inv1;
        }
        __syncthreads();
        if (mp == 0) {
            const float lam = tab[TAB_LAM]; float ss = 0.f;
#pragma unroll
            for (int d = 0; d < 4; ++d)
#pragma unroll
                for (int i = 0; i < 16; ++i) { const float o = O[d][i] * inv1 - lam * xb[((w * 4 + d) * 16 + i) * 64 + lane]; O[d][i] = o; ss += o * o; }
            ss += __shfl_xor(ss, 32);
            const float rstd = 0.8f * __builtin_amdgcn_rsqf(ss * (1.0f / 128.0f) + 1e-6f);
#pragma unroll
            for (int d = 0; d < 4; ++d)
#pragma unroll
                for (int a = 0; a < 4; ++a) { const int d0 = 32 * d + 8 * a + 4 * hh; const u32x2 z2 = zv[d][a]; const f32x4 g = gv[d][a];
                    const float o0 = O[d][4 * a] * rstd * g[0] * silu_f(bf_lo(z2.x)), o1 = O[d][4 * a + 1] * rstd * g[1] * silu_f(bf_hi(z2.x));
                    const float o2 = O[d][4 * a + 2] * rstd * g[2] * silu_f(bf_lo(z2.y)), o3 = O[d][4 * a + 3] * rstd * g[3] * silu_f(bf_hi(z2.y));
                    u32x2 ov; ov.x = cvt_pk_bf16(o0, o1); ov.y = cvt_pk_bf16(o2, o3); *(u32x2*)(mix + d0) = ov; }
        }
        __syncthreads();
    }
}

__device__ __forceinline__ void attn_phase(const Params& P, LAS unsigned char* lds) {
    int tid_ = threadIdx.x; asm volatile("" : "+v"(tid_)); const int tid = tid_;
    unsigned* ctr = (unsigned*)(P.ws + WS_CTL);
    LAS int* misc = (LAS int*)(lds + AL_MISC);
    const int xq = (int)(__builtin_amdgcn_s_getreg((3 << 11) | 20) & 7u);
    const bool bounded = ((const float*)(P.ws + WS_TAB))[TAB_DBOUND] <= 60.0f;
    for (;;) {
        if (tid == 0) { int u = -1;
            for (int k = 0; k < 8; ++k) { const int qi = (xq + k) & 7; const unsigned v = atomicAdd(ctr + qi, 1u); if (v < (unsigned)QN) { u = qi * QN + (int)v; break; } }
            misc[0] = u; }
        __syncthreads();
        const int u = misc[0];
        __syncthreads();
        if (u < 0) break;
        const int qi = u / QN, v = u % QN;
        if (v < 256) { const int bh = qi * 4 + (v >> 6), qb = 63 - (v & 63); if (bounded) attn_unit<1>(P, lds, bh >> 3, bh & 7, qb); else attn_unit<2>(P, lds, bh >> 3, bh & 7, qb); }
        else { const int v2 = v - 256; const int bh = qi * 4 + (v2 >> 5), qb = 31 - (v2 & 31); attn_unit<0>(P, lds, bh >> 3, bh & 7, qb); }
    }
}

__global__ void __launch_bounds__(NT, 2) hymba_fwd(Params P) {
    extern __shared__ __attribute__((aligned(16))) unsigned char lds_raw[];
    LAS unsigned char* lds = (LAS unsigned char*)lds_raw;
    cg::grid_group grid = cg::this_grid();
    unsigned char* ws = P.ws;
    const int G = gridDim.x, bx = blockIdx.x;

    volatile LAS unsigned* xst = (volatile LAS unsigned*)(lds + LDS_BYTES - 16);
    if (threadIdx.x < 2) xst[threadIdx.x] = 0u;
    __syncthreads();

    p0_prologue(P, lds);
    grid.sync();
    const XcdBarrier xbar = xcd_barrier_post((unsigned*)(ws + WS_BAR), xst);

    {
        pg8::Gemm g{(const bf16_t*)(ws + WS_U), (const bf16_t*)(ws + WS_WIN), M_, NP, DM}; pg8::StaticOrder S; S.init(M_, NP, G, bx);
        pg8::EpiProj E{(bf16_t*)(ws + WS_QKVZ), (const float*)(ws + WS_TAB) + TAB_GAIN, (LAS float*)(lds + pg8::STAGE_BYTES)};
        pg8::gemm_phase<pg8::EpiProj, pg8::StaticOrder, true, true>(lds, g, S, E);
    }
    {
        pg8::Gemm g{(const bf16_t*)(ws + WS_PB), (const bf16_t*)(ws + WS_WP), M_, DM, PLE}; pg8::StaticOrder S; S.init(M_, DM, G, bx);
        pg8::EpiPlain E{(bf16_t*)(ws + WS_E), DM};
        pg8::gemm_phase<pg8::EpiPlain, pg8::StaticOrder, true, true>(lds, g, S, E);
    }
    if (bx < 32) cumsum_seq(P, lds, bx);
    xcd_barrier(xbar);

    attn_phase(P, lds);
    xcd_barrier(xbar);

    {
        pg8::Gemm g{(const bf16_t*)(ws + WS_MIX), (const bf16_t*)(ws + WS_WOUT), M_, DM, DM}; pg8::StaticOrder S; S.init(M_, DM, G, bx);
        pg8::EpiOut E{P.in[I_X], (bf16_t*)(ws + WS_A2), (float*)(ws + WS_SUMSQ)};
        pg8::gemm_phase<pg8::EpiOut, pg8::StaticOrder, true, true>(lds, g, S, E);
    }
    xcd_barrier(xbar);
    {
        pg8::Gemm g{(const bf16_t*)(ws + WS_A2), (const bf16_t*)(ws + WS_WG), M_, DM, DM}; pg8::StaticOrder S; S.init(M_, DM, G, bx);
        pg8::EpiGate E{P.out, (const bf16_t*)(ws + WS_A2), (const bf16_t*)(ws + WS_E), (const float*)(ws + WS_SUMSQ)};
        pg8::gemm_phase<pg8::EpiGate, pg8::StaticOrder, true, true>(lds, g, S, E);
    }
}

extern "C" void kernel_launch(void* const* d_in, const int* in_sizes, int n_in, void* d_out, int out_size, void* d_ws, size_t ws_size, hipStream_t stream) {
    static int grid = 0;
    if (grid == 0) {
        if (n_in != 19 || out_size != M_ * DM || ws_size < WS_TOTAL) { fprintf(stderr, "kernel_launch: unexpected shapes (n_in %d, out %d, ws %zu < %zu)\n", n_in, out_size, ws_size, (size_t)WS_TOTAL); grid = -1; return; }
        int dev = 0, cus = 0, per_cu = 0;
        hipGetDevice(&dev); hipDeviceGetAttribute(&cus, hipDeviceAttributeMultiprocessorCount, dev);
        if (hipFuncSetAttribute((const void*)hymba_fwd, hipFuncAttributeMaxDynamicSharedMemorySize, LDS_BYTES) != hipSuccess) { fprintf(stderr, "kernel_launch: hipFuncSetAttribute failed\n"); grid = -1; return; }
        if (hipOccupancyMaxActiveBlocksPerMultiprocessor(&per_cu, (const void*)hymba_fwd, NT, LDS_BYTES) != hipSuccess || per_cu < 1) { fprintf(stderr, "kernel_launch: occupancy query gives %d\n", per_cu); per_cu = 1; }
        (void)hipGetLastError();
        grid = cus * (per_cu > 1 ? 1 : per_cu);
    }
    if (grid < 0) return;
    Params p{};
    for (int i = 0; i < 19; ++i) p.in[i] = (const float*)d_in[i];
    p.out = (float*)d_out; p.ws = (unsigned char*)d_ws;
    void* args[] = {&p};
    const hipError_t e = hipLaunchCooperativeKernel((const void*)hymba_fwd, dim3(grid), dim3(NT), args, LDS_BYTES, stream);
    if (e != hipSuccess) fprintf(stderr, "kernel_launch: cooperative launch failed: %s (grid %d)\n", hipGetErrorString(e), grid);
}
```
